# Optimizing an MI355X kernel written in HIP

```python
import math
import jax, jax.numpy as jnp
from jax import lax
import numpy as np

D_MODEL = 2048
BATCH = 16
SEQ = 2048
DEPTH = 4

N_BRANCH = 4
BRANCH_WIDTH = D_MODEL // 4
ROPE_THETA = 500000.0
Q_BLOCK = 128
NORM_EPS = 1e-5

DIFF_HEADS = 4
DIFF_HEAD_DIM = BRANCH_WIDTH // (2 * DIFF_HEADS)
DIFF_V_DIM = 2 * DIFF_HEAD_DIM
DIFF_ROT = DIFF_HEAD_DIM // 4

GLA_HEADS = 4
GLA_DK = BRANCH_WIDTH // 2 // GLA_HEADS
GLA_DV = BRANCH_WIDTH // GLA_HEADS
GLA_GATE_RANK = 16
GLA_TAU = 16.0
GLA_CHUNK = 64

MLA_HEADS = 4
MLA_NOPE = 128
MLA_ROPE = 64
MLA_V = BRANCH_WIDTH // MLA_HEADS
MLA_Q_RANK = 384
MLA_KV_RANK = 128

SSD_HEADDIM = 64
SSD_INNER = BRANCH_WIDTH
SSD_HEADS = SSD_INNER // SSD_HEADDIM
SSD_GROUPS = 2
SSD_STATE = 128
SSD_CONV = 4
SSD_CONV_DIM = SSD_INNER + 2 * SSD_GROUPS * SSD_STATE
SSD_CHUNK = 128

D_FF = 256 * ((8 * D_MODEL // 3 + 255) // 256)

ALPHA = (2 * DEPTH) ** 0.25
BETA = (8 * DEPTH) ** -0.25

IN_SPLITS = [
    DIFF_HEADS * 2 * DIFF_HEAD_DIM, DIFF_HEADS * 2 * DIFF_HEAD_DIM, DIFF_HEADS * DIFF_V_DIM,
    GLA_HEADS * GLA_DK, GLA_HEADS * GLA_DK, GLA_HEADS * GLA_DV, GLA_GATE_RANK, BRANCH_WIDTH,
    MLA_Q_RANK, MLA_KV_RANK, MLA_ROPE,
    SSD_INNER, SSD_CONV_DIM, SSD_HEADS,
    N_BRANCH * D_MODEL,
]
N_IN = sum(IN_SPLITS)

kernel_name = "hybrid_diff_gla_mla_ssd_macaron_deepnorm"


def split_cols(t, sizes):
    return jnp.split(t, [int(i) for i in np.cumsum(sizes)[:-1]], axis=-1)


def layer_norm(x, g, b):
    xf = x.astype(jnp.float32)
    mu = jnp.mean(xf, axis=-1, keepdims=True)
    xc = xf - mu
    var = jnp.mean(xc * xc, axis=-1, keepdims=True)
    return (xc * lax.rsqrt(var + NORM_EPS) * g + b).astype(x.dtype)


def rms_norm(x, g):
    xf = x.astype(jnp.float32)
    return (xf * lax.rsqrt(jnp.mean(xf * xf, axis=-1, keepdims=True) + NORM_EPS) * g).astype(x.dtype)


def swiglu(h, w_gu, w_down):
    gate, up = jnp.split(h @ w_gu, 2, axis=-1)
    return (jax.nn.silu(gate) * up) @ w_down


def rope_tables(positions, rot_dim):
    inv = ROPE_THETA ** (-jnp.arange(0, rot_dim, 2, dtype=jnp.float32) / rot_dim)
    ang = positions.astype(jnp.float32)[..., None] * inv
    return jnp.cos(ang), jnp.sin(ang)


def apply_rope(x, cos, sin):
    x1, x2 = jnp.split(x, 2, axis=-1)
    return jnp.concatenate([x1 * cos - x2 * sin, x1 * sin + x2 * cos], axis=-1).astype(x.dtype)


def partial_rope(x, cos, sin, rot):
    return jnp.concatenate([apply_rope(x[..., :rot], cos, sin), x[..., rot:]], axis=-1)


def causal_softmax_attend(q, k, v, scale):
    bsz, m, nh, s, dk = q.shape
    nb = s // Q_BLOCK
    q_blocks = jnp.moveaxis(q.reshape(bsz, m, nh, nb, Q_BLOCK, dk), 3, 0)
    key_pos = jnp.arange(s)

    def one_block(args):
        qb, i = args
        sc = jnp.einsum('bmhqd,bmhkd->bmhqk', qb, k).astype(jnp.float32) * scale
        q_pos = i * Q_BLOCK + jnp.arange(Q_BLOCK)
        sc = jnp.where(q_pos[:, None] >= key_pos[None, :], sc, -jnp.inf)
        p = jax.nn.softmax(sc, axis=-1).astype(v.dtype)
        return jnp.einsum('bmhqk,bhkd->bmhqd', p, v)

    o = lax.map(one_block, (q_blocks, jnp.arange(nb)))
    return jnp.moveaxis(o, 0, 3).reshape(bsz, m, nh, s, v.shape[-1])


def chunk_scan(decay, inc):
    def step(state, xs):
        d, u = xs
        return (d * state + u).astype(state.dtype), state
    _, prev = lax.scan(step, jnp.zeros_like(inc[0]), (decay, inc))
    return prev


def diff_attention_branch(q, k, v, lam_params, subln_g, cos, sin, layer):
    bsz, s, _ = q.shape
    q = q.reshape(bsz, s, DIFF_HEADS, 2, DIFF_HEAD_DIM).transpose(0, 3, 2, 1, 4)
    k = k.reshape(bsz, s, DIFF_HEADS, 2, DIFF_HEAD_DIM).transpose(0, 3, 2, 1, 4)
    c, sn = cos[:, None, None], sin[:, None, None]
    q = partial_rope(q, c, sn, DIFF_ROT)
    k = partial_rope(k, c, sn, DIFF_ROT)
    v = v.reshape(bsz, s, DIFF_HEADS, DIFF_V_DIM).transpose(0, 2, 1, 3)
    o = causal_softmax_attend(q, k, v, DIFF_HEAD_DIM ** -0.5)
    lam_init = 0.8 - 0.6 * math.exp(-0.3 * layer)
    lp = lam_params.astype(jnp.float32)
    lam = jnp.exp(jnp.sum(lp[0] * lp[1])) - jnp.exp(jnp.sum(lp[2] * lp[3])) + lam_init
    o = o[:, 0] - lam.astype(o.dtype) * o[:, 1]
    o = rms_norm(o, subln_g) * (1.0 - lam_init)
    return o.transpose(0, 2, 1, 3).reshape(bsz, s, BRANCH_WIDTH)


def gla_branch(q, k, v, g_low, r, w_gate2, b_gate, norm_g):
    bsz, s, _ = q.shape
    nc = s // GLA_CHUNK

    def heads(t, d):
        return t.reshape(bsz, s, GLA_HEADS, d).transpose(0, 2, 1, 3).reshape(bsz, GLA_HEADS, nc, GLA_CHUNK, d)

    g = jax.nn.log_sigmoid((g_low @ w_gate2 + b_gate).astype(jnp.float32)) / GLA_TAU
    qc = heads(q, GLA_DK) * GLA_DK ** -0.5
    kc = heads(k, GLA_DK)
    vc = heads(v, GLA_DV)
    b = jnp.cumsum(heads(g, GLA_DK), axis=3)
    b_last = b[:, :, :, -1:, :]
    q_t = qc * jnp.exp(b)
    k_t = kc * jnp.exp(-b)
    mask = jnp.tril(jnp.ones((GLA_CHUNK, GLA_CHUNK), dtype=bool))
    att = jnp.where(mask, jnp.einsum('bhnid,bhnjd->bhnij', q_t, k_t), 0.0)
    o_intra = jnp.einsum('bhnij,bhnje->bhnie', att, vc)
    inc = jnp.einsum('bhnjd,bhnje->bhnde', kc * jnp.exp(b_last - b), vc)
    decay = jnp.swapaxes(jnp.exp(b_last), -1, -2)
    prev = jnp.moveaxis(chunk_scan(jnp.moveaxis(decay, 2, 0), jnp.moveaxis(inc, 2, 0)), 0, 2)
    o = o_intra + jnp.einsum('bhnid,bhnde->bhnie', q_t, prev)
    o = rms_norm(o, norm_g).reshape(bsz, GLA_HEADS, s, GLA_DV).transpose(0, 2, 1, 3).reshape(bsz, s, BRANCH_WIDTH)
    return (o * jax.nn.silu(r)).astype(q.dtype)


def mla_branch(c_q, c_kv, k_r, cos, sin, q_norm_g, w_uq, kv_norm_g, w_ukv):
    bsz, s, _ = c_q.shape
    q = (rms_norm(c_q, q_norm_g) @ w_uq).reshape(bsz, s, MLA_HEADS, MLA_NOPE + MLA_ROPE)
    q = jnp.concatenate([q[..., :MLA_NOPE], apply_rope(q[..., MLA_NOPE:], cos[:, :, None], sin[:, :, None])], axis=-1)
    kv = (rms_norm(c_kv, kv_norm_g) @ w_ukv).reshape(bsz, s, MLA_HEADS, MLA_NOPE + MLA_V)
    k_nope, v = kv[..., :MLA_NOPE], kv[..., MLA_NOPE:]
    k_rope = jnp.broadcast_to(apply_rope(k_r, cos, sin)[:, :, None, :], (bsz, s, MLA_HEADS, MLA_ROPE))
    k = jnp.concatenate([k_nope, k_rope], axis=-1)
    o = causal_softmax_attend(q.transpose(0, 2, 1, 3)[:, None], k.transpose(0, 2, 1, 3)[:, None],
                              v.transpose(0, 2, 1, 3), (MLA_NOPE + MLA_ROPE) ** -0.5)[:, 0]
    return o.transpose(0, 2, 1, 3).reshape(bsz, s, BRANCH_WIDTH)


def causal_depthwise_conv(x, w, b):
    kw, ch = w.shape
    out = lax.conv_general_dilated(x, w[:, None, :].astype(x.dtype), window_strides=(1,), padding=[(kw - 1, 0)],
                                   dimension_numbers=('NWC', 'WIO', 'NWC'), feature_group_count=ch)
    return out + b


def ssd_chunked(x, dt, a, bm, cm):
    bsz, s, nh, p = x.shape
    g, n = bm.shape[-2:]
    hg = nh // g
    nc = s // SSD_CHUNK
    xdt = (x * dt[..., None]).reshape(bsz, nc, SSD_CHUNK, g, hg, p)
    a_cum = jnp.cumsum((dt * a).reshape(bsz, nc, SSD_CHUNK, g, hg), axis=2)
    bc = bm.reshape(bsz, nc, SSD_CHUNK, g, n)
    cc = cm.reshape(bsz, nc, SSD_CHUNK, g, n)
    mask = jnp.tril(jnp.ones((SSD_CHUNK, SSD_CHUNK), dtype=bool))[:, :, None, None]
    seg = a_cum[:, :, :, None] - a_cum[:, :, None, :]
    lmat = jnp.exp(jnp.where(mask, seg, -jnp.inf))
    cb = jnp.einsum('bnigs,bnjgs->bnijg', cc, bc)
    y_diag = jnp.einsum('bnijg,bnijgh,bnjghp->bnighp', cb, lmat, xdt)
    decay_states = jnp.exp(a_cum[:, :, -1:] - a_cum)
    inc = jnp.einsum('bnjgs,bnjgh,bnjghp->bnghps', bc, decay_states, xdt)
    chunk_decay = jnp.exp(a_cum[:, :, -1])[..., None, None]
    prev = jnp.moveaxis(chunk_scan(jnp.moveaxis(chunk_decay, 1, 0), jnp.moveaxis(inc, 1, 0)), 0, 1)
    y_off = jnp.einsum('bnigs,bnghps,bnigh->bnighp', cc, prev, jnp.exp(a_cum))
    return (y_diag + y_off).reshape(bsz, s, nh, p)


def ssd_branch(z, xbc, dt, conv_w, conv_b, dt_bias, a_log, d_skip, norm_g):
    bsz, s, _ = z.shape
    xbc = jax.nn.silu(causal_depthwise_conv(xbc, conv_w, conv_b))
    xs, bm, cm = split_cols(xbc, [SSD_INNER, SSD_GROUPS * SSD_STATE, SSD_GROUPS * SSD_STATE])
    xs = xs.reshape(bsz, s, SSD_HEADS, SSD_HEADDIM)
    dt = jax.nn.softplus((dt + dt_bias).astype(jnp.float32))
    a = -jnp.exp(a_log.astype(jnp.float32))
    y = ssd_chunked(xs, dt, a, bm.reshape(bsz, s, SSD_GROUPS, SSD_STATE), cm.reshape(bsz, s, SSD_GROUPS, SSD_STATE))
    y = y + d_skip[:, None] * xs
    y = (y.reshape(bsz, s, SSD_INNER) * jax.nn.silu(z)).reshape(bsz, s, SSD_GROUPS, SSD_INNER // SSD_GROUPS)
    y = rms_norm(y, norm_g.reshape(SSD_GROUPS, SSD_INNER // SSD_GROUPS)).reshape(bsz, s, SSD_INNER)
    return y.astype(z.dtype)


def hybrid_mixer(h, layer, cos_d, sin_d, cos_m, sin_m, w_in, b_gate, diff_lambda, diff_subln_g,
                 gla_w_gate2, gla_b_gate, gla_norm_g, mla_q_norm_g, mla_w_uq, mla_kv_norm_g, mla_w_ukv,
                 ssd_conv_w, ssd_conv_b, ssd_dt_bias, ssd_a_log, ssd_d, ssd_norm_g, w_branch, w_out):
    bsz, s, _ = h.shape
    (a_q, a_k, a_v, b_q, b_k, b_v, b_glow, b_r, c_q, c_kv, c_kr,
     d_z, d_xbc, d_dt, gate_logits) = split_cols(h @ w_in, IN_SPLITS)
    o_a = diff_attention_branch(a_q, a_k, a_v, diff_lambda, diff_subln_g, cos_d, sin_d, layer)
    o_b = gla_branch(b_q, b_k, b_v, b_glow, b_r, gla_w_gate2, gla_b_gate, gla_norm_g)
    o_c = mla_branch(c_q, c_kv, c_kr, cos_m, sin_m, mla_q_norm_g, mla_w_uq, mla_kv_norm_g, mla_w_ukv)
    o_d = ssd_branch(d_z, d_xbc, d_dt, ssd_conv_w, ssd_conv_b, ssd_dt_bias, ssd_a_log, ssd_d, ssd_norm_g)
    gates = jax.nn.sigmoid((gate_logits + b_gate).astype(jnp.float32)).astype(h.dtype)
    gates = gates.reshape(bsz, s, N_BRANCH, D_MODEL)
    outs = (o_a, o_b, o_c, o_d)
    merged = gates[:, :, 0] * (o_a @ w_branch[0])
    for i in range(1, N_BRANCH):
        merged = merged + gates[:, :, i] * (outs[i] @ w_branch[i])
    return merged @ w_out


def setup_inputs(seed: int = 0) -> dict:
    key = jax.random.key(seed)
    ks = jax.random.split(key, 32)
    f32 = jnp.float32

    def nrm(k, shape, fan_in, gain=1.0):
        return jax.random.normal(k, shape, f32) * (gain * fan_in ** -0.5)

    def gain(k, shape):
        return 1.0 + 0.02 * jax.random.normal(k, shape, f32)

    def small(k, shape):
        return 0.02 * jax.random.normal(k, shape, f32)

    x = jax.random.normal(ks[0], (BATCH, SEQ, D_MODEL), f32)
    positions = (jax.random.randint(ks[1], (BATCH, 1), 0, 4096) + jnp.arange(SEQ)[None, :]).astype(jnp.int32)
    dt0 = jnp.exp(jax.random.uniform(ks[22], (DEPTH, SSD_HEADS), f32, math.log(1e-3), math.log(1e-1)))
    return {
        "x": x,
        "positions": positions,
        "ln_g": gain(ks[2], (DEPTH, 3, D_MODEL)),
        "ln_b": small(ks[3], (DEPTH, 3, D_MODEL)),
        "ffn1_w_gu": nrm(ks[4], (DEPTH, D_MODEL, 2 * D_FF), D_MODEL),
        "ffn1_w_down": nrm(ks[5], (DEPTH, D_FF, D_MODEL), D_FF, BETA),
        "ffn2_w_gu": nrm(ks[6], (DEPTH, D_MODEL, 2 * D_FF), D_MODEL),
        "ffn2_w_down": nrm(ks[7], (DEPTH, D_FF, D_MODEL), D_FF, BETA),
        "w_in": nrm(ks[8], (DEPTH, D_MODEL, N_IN), D_MODEL),
        "b_gate": small(ks[9], (DEPTH, N_BRANCH * D_MODEL)),
        "diff_lambda": 0.1 * jax.random.normal(ks[10], (DEPTH, 4, DIFF_HEAD_DIM), f32),
        "diff_subln_g": gain(ks[11], (DEPTH, DIFF_V_DIM)),
        "gla_w_gate2": nrm(ks[12], (DEPTH, GLA_GATE_RANK, GLA_HEADS * GLA_DK), GLA_GATE_RANK),
        "gla_b_gate": small(ks[13], (DEPTH, GLA_HEADS * GLA_DK)),
        "gla_norm_g": gain(ks[14], (DEPTH, GLA_DV)),
        "mla_q_norm_g": gain(ks[15], (DEPTH, MLA_Q_RANK)),
        "mla_w_uq": nrm(ks[16], (DEPTH, MLA_Q_RANK, MLA_HEADS * (MLA_NOPE + MLA_ROPE)), MLA_Q_RANK),
        "mla_kv_norm_g": gain(ks[17], (DEPTH, MLA_KV_RANK)),
        "mla_w_ukv": nrm(ks[18], (DEPTH, MLA_KV_RANK, MLA_HEADS * (MLA_NOPE + MLA_V)), MLA_KV_RANK),
        "ssd_conv_w": jax.random.uniform(ks[19], (DEPTH, SSD_CONV, SSD_CONV_DIM), f32, -SSD_CONV ** -0.5, SSD_CONV ** -0.5),
        "ssd_conv_b": small(ks[20], (DEPTH, SSD_CONV_DIM)),
        "ssd_dt_bias": dt0 + jnp.log(-jnp.expm1(-dt0)),
        "ssd_a_log": jnp.log(jax.random.uniform(ks[23], (DEPTH, SSD_HEADS), f32, 1.0, 16.0)),
        "ssd_d": gain(ks[24], (DEPTH, SSD_HEADS)),
        "ssd_norm_g": gain(ks[25], (DEPTH, SSD_INNER)),
        "w_branch": nrm(ks[26], (DEPTH, N_BRANCH, BRANCH_WIDTH, D_MODEL), BRANCH_WIDTH),
        "w_out": nrm(ks[27], (DEPTH, D_MODEL, D_MODEL), D_MODEL, BETA),
    }


def reference(x, positions, ln_g, ln_b, ffn1_w_gu, ffn1_w_down, ffn2_w_gu, ffn2_w_down, w_in, b_gate,
              diff_lambda, diff_subln_g, gla_w_gate2, gla_b_gate, gla_norm_g, mla_q_norm_g, mla_w_uq,
              mla_kv_norm_g, mla_w_ukv, ssd_conv_w, ssd_conv_b, ssd_dt_bias, ssd_a_log, ssd_d, ssd_norm_g,
              w_branch, w_out):
    cos_d, sin_d = rope_tables(positions, DIFF_ROT)
    cos_m, sin_m = rope_tables(positions, MLA_ROPE)
    h = x
    for l in range(DEPTH):
        h = layer_norm(ALPHA * h + 0.5 * swiglu(h, ffn1_w_gu[l], ffn1_w_down[l]), ln_g[l, 0], ln_b[l, 0])
        mix = hybrid_mixer(h, l, cos_d, sin_d, cos_m, sin_m, w_in[l], b_gate[l], diff_lambda[l], diff_subln_g[l],
                           gla_w_gate2[l], gla_b_gate[l], gla_norm_g[l], mla_q_norm_g[l], mla_w_uq[l],
                           mla_kv_norm_g[l], mla_w_ukv[l], ssd_conv_w[l], ssd_conv_b[l], ssd_dt_bias[l],
                           ssd_a_log[l], ssd_d[l], ssd_norm_g[l], w_branch[l], w_out[l])
        h = layer_norm(ALPHA * h + mix, ln_g[l, 1], ln_b[l, 1])
        h = layer_norm(ALPHA * h + 0.5 * swiglu(h, ffn2_w_gu[l], ffn2_w_down[l]), ln_g[l, 2], ln_b[l, 2])
    return h
```

```cpp
#include <hip/hip_runtime.h>
#include <cstdio>
#include <cstdint>
#include <cmath>
namespace pg8 {
#define PG8_LAS __attribute__((address_space(3)))
typedef unsigned short bf16_t;
typedef short bf16x8 __attribute__((ext_vector_type(8)));
typedef float f32x4 __attribute__((ext_vector_type(4)));
typedef float f32x2 __attribute__((ext_vector_type(2)));
typedef unsigned u32x4 __attribute__((ext_vector_type(4)));
constexpr int BM = 256, BK = 64, HALF = 128, HTB = HALF * BK * 2  , STAGE_BYTES = 8 * HTB, NXCD = 8, WGM = 8;

__host__ __device__ __forceinline__ int lds_byte(int r, int c) { const int st = (r >> 4) * 2 + (c >> 5), rr = r & 15, cc = c & 31, ob = rr * 64 + cc * 2; return st * 1024 + (ob ^ (((ob >> 9) & 1) << 5)); }
__host__ __device__ __forceinline__ void stage_rc(int b, int& R, int& C) { const int st = b / 1024, sb = b % 1024, swz = sb ^ (((sb >> 9) & 1) << 5); R = (st >> 1) * 16 + swz / 64; C = (st & 1) * 32 + (swz % 64) / 2; }
__host__ __device__ __forceinline__ int perm32(int rho) { const int n = rho >> 4, i = rho & 15; return 8 * (i >> 2) + 4 * n + (i & 3); }

struct Unit { int pm, pn, pz; };
struct Gemm { const bf16_t* A; const bf16_t* Bt; int M, N, K, lda, ldb; size_t zA, zB; };

struct StaticOrder {
    int nM, nN, nwg, G, c, Z;
    __host__ __device__ void init(int M, int N, int G_, int c_, int Z_ = 1) { nM = M / BM; nN = N / BM; nwg = nM * nN; G = G_; c = c_; Z = Z_; }
    __host__ __device__ bool next(int i, Unit& u) const {
        const long L = (long)(i / Z) * G + c; if (L >= nwg) return false;
        int wgid = (int)L; { const int q = nwg / NXCD, r = nwg % NXCD, xcd = wgid % NXCD, off = wgid / NXCD; wgid = (xcd < r ? xcd * (q + 1) : r * (q + 1) + (xcd - r) * q) + off; }
        const int nig = WGM * nN, gid = wgid / nig, fm = gid * WGM, gsz = (nM - fm) < WGM ? (nM - fm) : WGM;
        u.pm = fm + ((wgid % nig) % gsz); u.pn = (wgid % nig) / gsz; u.pz = i % Z; return true;
    }
    __device__ __forceinline__ void a_ready(const Unit&) const {}
    __device__ __forceinline__ void done(const Unit&) const {}
};

typedef __bf16 bf16x2_t __attribute__((ext_vector_type(2)));
__device__ __forceinline__ unsigned cvt_pk_bf16(float lo, float hi) { f32x2 v = {lo, hi}; bf16x2_t b = __builtin_convertvector(v, bf16x2_t); return __builtin_bit_cast(unsigned, b); }
__device__ __forceinline__ float bfl(unsigned w) { return __uint_as_float(w << 16); }
__device__ __forceinline__ float bfh(unsigned w) { return __uint_as_float(w & 0xffff0000u); }
__device__ __forceinline__ float fsigmoid(float x) { return __builtin_amdgcn_rcpf(1.0f + __builtin_amdgcn_exp2f(-1.4426950408889634f * x)); }

struct EpiBf16 {
    static constexpr bool PERM = true, AFTER_DRAIN = false;
    bf16_t* O; int ldc;
    __device__ __forceinline__ void operator()(const f32x4 (&acc)[2][2][4][2], const Unit& u, int wr, int wc, int fr, int fq) const {
        const int row0 = u.pm * BM + wr * 64 + fr, col0 = u.pn * BM + wc * 32 + 8 * fq;
#pragma unroll
        for (int ai = 0; ai < 2; ++ai)
#pragma unroll
            for (int m = 0; m < 4; ++m) { bf16_t* rowp = O + (size_t)(row0 + ai * HALF + m * 16) * ldc + col0;
#pragma unroll
                for (int bj = 0; bj < 2; ++bj) { const f32x4 v0 = acc[ai][bj][m][0], v1 = acc[ai][bj][m][1];
                    u32x4 w; w.x = cvt_pk_bf16(v0[0], v0[1]); w.y = cvt_pk_bf16(v0[2], v0[3]); w.z = cvt_pk_bf16(v1[0], v1[1]); w.w = cvt_pk_bf16(v1[2], v1[3]);
                    *(u32x4*)(rowp + bj * HALF) = w; } }
    }
};
struct EpiSwiglu {
    static constexpr bool PERM = true, AFTER_DRAIN = false;
    bf16_t* O; int ldc; float* nanp;
    __device__ __forceinline__ void operator()(const f32x4 (&acc)[2][2][4][2], const Unit& u, int wr, int wc, int fr, int fq) const {
        const int row0 = u.pm * BM + wr * 64 + fr, col0 = u.pn * HALF + wc * 32 + 8 * fq;
#pragma unroll
        for (int ai = 0; ai < 2; ++ai)
#pragma unroll
            for (int m = 0; m < 4; ++m) { bf16_t* rowp = O + (size_t)(row0 + ai * HALF + m * 16) * ldc + col0;
                float r[8];
#pragma unroll
                for (int n = 0; n < 2; ++n)
#pragma unroll
                    for (int j = 0; j < 4; ++j) { const float gt = acc[ai][0][m][n][j], up = acc[ai][1][m][n][j]; r[n * 4 + j] = gt * fsigmoid(gt) * up; }
                u32x4 w; w.x = cvt_pk_bf16(r[0], r[1]); w.y = cvt_pk_bf16(r[2], r[3]); w.z = cvt_pk_bf16(r[4], r[5]); w.w = cvt_pk_bf16(r[6], r[7]);
                if (nanp) { const u32x4 o = *(const u32x4*)rowp; if (o.x != w.x || o.y != w.y || o.z != w.z || o.w != w.w) *nanp = __builtin_nanf(""); } else *(u32x4*)rowp = w; }
    }
};
struct EpiResidual {
    static constexpr bool PERM = false, AFTER_DRAIN = false;
    const float* base; float* out; int ldc; float alpha, s;
    __device__ __forceinline__ void operator()(const f32x4 (&acc)[2][2][4][2], const Unit& u, int wr, int wc, int fr, int fq) const {
        const int row0 = u.pm * BM + wr * 64 + fr, col0 = u.pn * BM + wc * 32 + 4 * fq;
#pragma unroll
        for (int ai = 0; ai < 2; ++ai)
#pragma unroll
            for (int m = 0; m < 4; ++m) { const size_t off = (size_t)(row0 + ai * HALF + m * 16) * ldc + col0;
#pragma unroll
                for (int bj = 0; bj < 2; ++bj)
#pragma unroll
                    for (int n = 0; n < 2; ++n) { const f32x4 bs = *(const f32x4*)(base + off + bj * HALF + n * 16); *(f32x4*)(out + off + bj * HALF + n * 16) = bs * alpha + acc[ai][bj][m][n] * s; } }
    }
};
struct EpiWin {
    static constexpr bool PERM = true, AFTER_DRAIN = false;
    bf16_t* proj; int ldp; int npt; bf16_t* gates; int ldg; const float* bias; unsigned* nanp;
    __device__ __forceinline__ void put(bf16_t* dst, u32x4 w) const {
        if (nanp) { const u32x4 o = *(const u32x4*)dst; if (o.x != w.x || o.y != w.y || o.z != w.z || o.w != w.w) *nanp = 1u; } else *(u32x4*)dst = w; }
    __device__ __forceinline__ void operator()(const f32x4 (&acc)[2][2][4][2], const Unit& u, int wr, int wc, int fr, int fq) const {
        const int row0 = u.pm * BM + wr * 64 + fr;
        if (u.pn < npt) {
            const int col0 = u.pn * BM + wc * 32 + 8 * fq;
#pragma unroll
            for (int ai = 0; ai < 2; ++ai)
#pragma unroll
                for (int m = 0; m < 4; ++m) { bf16_t* rowp = proj + (size_t)(row0 + ai * HALF + m * 16) * ldp + col0;
#pragma unroll
                    for (int bj = 0; bj < 2; ++bj) { const f32x4 v0 = acc[ai][bj][m][0], v1 = acc[ai][bj][m][1];
                        u32x4 w; w.x = cvt_pk_bf16(v0[0], v0[1]); w.y = cvt_pk_bf16(v0[2], v0[3]); w.z = cvt_pk_bf16(v1[0], v1[1]); w.w = cvt_pk_bf16(v1[2], v1[3]);
                        put(rowp + bj * HALF, w); } }
        } else {
            const int col0 = (u.pn - npt) * BM + wc * 32 + 8 * fq;
            f32x4 bv[2][2];
#pragma unroll
            for (int bj = 0; bj < 2; ++bj)
#pragma unroll
                for (int n = 0; n < 2; ++n) bv[bj][n] = *(const f32x4*)(bias + col0 + bj * HALF + 4 * n);
#pragma unroll
            for (int ai = 0; ai < 2; ++ai)
#pragma unroll
                for (int m = 0; m < 4; ++m) { bf16_t* rowp = gates + (size_t)(row0 + ai * HALF + m * 16) * ldg + col0;
#pragma unroll
                    for (int bj = 0; bj < 2; ++bj) { f32x4 v0 = acc[ai][bj][m][0] + bv[bj][0], v1 = acc[ai][bj][m][1] + bv[bj][1];
#pragma unroll
                        for (int j = 0; j < 4; ++j) { v0[j] = fsigmoid(v0[j]); v1[j] = fsigmoid(v1[j]); }
                        u32x4 w; w.x = cvt_pk_bf16(v0[0], v0[1]); w.y = cvt_pk_bf16(v0[2], v0[3]); w.z = cvt_pk_bf16(v1[0], v1[1]); w.w = cvt_pk_bf16(v1[2], v1[3]);
                        put(rowp + bj * HALF, w); } }
        }
    }
};
struct EpiMerge {
    static constexpr bool PERM = true, AFTER_DRAIN = false;
    bf16_t* merged; int ldc; const bf16_t* gates; int ldg;
    __device__ __forceinline__ void operator()(const f32x4 (&acc)[2][2][4][2], const Unit& u, int wr, int wc, int fr, int fq) const {
        const int row0 = u.pm * BM + wr * 64 + fr, col0 = u.pn * BM + wc * 32 + 8 * fq;
#pragma unroll
        for (int ai = 0; ai < 2; ++ai)
#pragma unroll
            for (int m = 0; m < 4; ++m) { const size_t row = (size_t)(row0 + ai * HALF + m * 16);
#pragma unroll
                for (int bj = 0; bj < 2; ++bj) {
                    const u32x4 g = *(const u32x4*)(gates + row * ldg + (size_t)u.pz * ldc + col0 + bj * HALF);
                    u32x4 pv = (u32x4){0u, 0u, 0u, 0u};
                    if (u.pz > 0) pv = *(const u32x4*)(merged + row * ldc + col0 + bj * HALF);
                    const f32x4 v0 = acc[ai][bj][m][0], v1 = acc[ai][bj][m][1];
                    u32x4 w;
                    w.x = cvt_pk_bf16(bfl(pv.x) + bfl(g.x) * v0[0], bfh(pv.x) + bfh(g.x) * v0[1]);
                    w.y = cvt_pk_bf16(bfl(pv.y) + bfl(g.y) * v0[2], bfh(pv.y) + bfh(g.y) * v0[3]);
                    w.z = cvt_pk_bf16(bfl(pv.z) + bfl(g.z) * v1[0], bfh(pv.z) + bfh(g.z) * v1[1]);
                    w.w = cvt_pk_bf16(bfl(pv.w) + bfl(g.w) * v1[2], bfh(pv.w) + bfh(g.w) * v1[3]);
                    *(u32x4*)(merged + row * ldc + col0 + bj * HALF) = w; } }
    }
};

template <class Epi, class Sched, bool ALIGN_EPI = false, bool SP2 = false>
__device__ __forceinline__ void gemm_phase(PG8_LAS unsigned char* lds, const Gemm g, const Sched& S, const Epi& E) {
    int tid_ = threadIdx.x; asm volatile("" : "+v"(tid_));
    const int tid = tid_, wid = __builtin_amdgcn_readfirstlane(tid >> 6), lane = tid & 63, wr = wid >> 2, wc = wid & 3, fr = lane & 15, fq = lane >> 4;
    const int K = g.K, nt = K / BK;
    unsigned voffA[2], voffB[2];
#pragma unroll
    for (int i = 0; i < 2; ++i) { int R, C; stage_rc(tid * 16 + i * 8192, R, C); const int Rb = Epi::PERM ? ((R & ~31) + perm32(R & 31)) : R;
        voffA[i] = (unsigned)(R * g.lda + C) * 2u; voffB[i] = (unsigned)(Rb * g.ldb + C) * 2u; }
    const size_t kstep = (size_t)(BK * 2);
    const size_t hstepA = (size_t)HALF * g.lda * 2, hstepB = (size_t)HALF * g.ldb * 2;
    const size_t tstepA = 2 * hstepA, tstepB = 2 * hstepB;
    const unsigned ldsw = (unsigned)wid * 1024u;
    const int aoff = lds_byte(wr * 64 + fr, fq * 8), boff = lds_byte(wc * 32 + fr, fq * 8);
#define PG8_SA(b, h) (((b) * 2 + (h)) * HTB)
#define PG8_SB(b, h) ((4 + (b) * 2 + (h)) * HTB)
#define PG8_STAGE(bufoff, gbase, voff) do { _Pragma("unroll") for (int _i = 0; _i < 2; ++_i) \
        __builtin_amdgcn_global_load_lds((const unsigned*)((const char*)(gbase) + (voff)[_i]), (PG8_LAS unsigned*)(lds + (bufoff) + ldsw + _i * 8192), 16, 0, 0); } while (0)
#define PG8_LDA(dst, b, h) do { _Pragma("unroll") for (int m = 0; m < 4; ++m) _Pragma("unroll") for (int k = 0; k < 2; ++k) dst[m][k] = *(const PG8_LAS bf16x8*)(lds + PG8_SA(b, h) + aoff + m * 2048 + k * 1024); } while (0)
#define PG8_LDB(dst, b, h) do { _Pragma("unroll") for (int n = 0; n < 2; ++n) _Pragma("unroll") for (int k = 0; k < 2; ++k) dst[n][k] = *(const PG8_LAS bf16x8*)(lds + PG8_SB(b, h) + boff + n * 2048 + k * 1024); } while (0)
#define PG8_MMA(ai, bj, At, Bt) do { __builtin_amdgcn_s_setprio(1); _Pragma("unroll") for (int m = 0; m < 4; ++m) _Pragma("unroll") for (int n = 0; n < 2; ++n) _Pragma("unroll") for (int k = 0; k < 2; ++k) \
        acc[ai][bj][m][n] = __builtin_amdgcn_mfma_f32_16x16x32_bf16(Bt[n][k], At[m][k], acc[ai][bj][m][n], 0, 0, 0); __builtin_amdgcn_s_setprio(0); } while (0)
#define PG8_WAIT_V(n) asm volatile("s_waitcnt vmcnt(" #n ")" ::: "memory")
#ifdef DBG_VM0
#define PG8_WAIT_VK PG8_WAIT_V(0)
#else
#define PG8_WAIT_VK PG8_WAIT_V(8)
#endif
#define PG8_WAIT_L(n) asm volatile("s_waitcnt lgkmcnt(" #n ")" ::: "memory")
#define PG8_BAR __builtin_amdgcn_s_barrier()
#define PG8_SCHED __builtin_amdgcn_sched_barrier(0)
    Unit cur, nxt; int ui = 0;
    if (!S.next(0, cur)) return;
    f32x4 acc[2][2][4][2];
#pragma unroll
    for (int a = 0; a < 2; ++a)
#pragma unroll
        for (int b = 0; b < 2; ++b)
#pragma unroll
            for (int m = 0; m < 4; ++m)
#pragma unroll
                for (int n = 0; n < 2; ++n) acc[a][b][m][n] = (f32x4){0.f, 0.f, 0.f, 0.f};
    bf16x8 At[4][2], B0[2][2], B1[2][2];
    const char* cA = (const char*)g.A + (size_t)cur.pm * tstepA + (size_t)cur.pz * g.zA; const char* cB = (const char*)g.Bt + (size_t)cur.pn * tstepB + (size_t)cur.pz * g.zB;
    S.a_ready(cur);
    if constexpr (SP2) {
        PG8_STAGE(PG8_SB(0, 0), cB, voffB); PG8_STAGE(PG8_SB(0, 1), cB + hstepB, voffB); PG8_STAGE(PG8_SA(0, 0), cA, voffA); PG8_STAGE(PG8_SA(0, 1), cA + hstepA, voffA);
        if (wr == 1) PG8_BAR;
        PG8_WAIT_V(2); PG8_BAR;
        PG8_STAGE(PG8_SB(1, 0), cB + kstep, voffB); PG8_STAGE(PG8_SA(1, 0), cA + kstep, voffA); PG8_STAGE(PG8_SB(1, 1), cB + hstepB + kstep, voffB);
        PG8_WAIT_V(6); PG8_BAR;
    } else {
        PG8_STAGE(PG8_SB(0, 0), cB, voffB); PG8_STAGE(PG8_SA(0, 0), cA, voffA); PG8_STAGE(PG8_SB(0, 1), cB + hstepB, voffB); PG8_STAGE(PG8_SA(0, 1), cA + hstepA, voffA);
        if (wr == 1) PG8_BAR;
        PG8_WAIT_V(4); PG8_BAR;
        PG8_STAGE(PG8_SB(1, 0), cB + kstep, voffB); PG8_STAGE(PG8_SA(1, 0), cA + kstep, voffA); PG8_STAGE(PG8_SB(1, 1), cB + hstepB + kstep, voffB);
        PG8_WAIT_V(6); PG8_BAR;
    }
    for (;;) {
        const bool has_next = S.next(ui + 1, nxt);
        const char* nA = has_next ? (const char*)g.A + (size_t)nxt.pm * tstepA + (size_t)nxt.pz * g.zA : cA; const char* nB = has_next ? (const char*)g.Bt + (size_t)nxt.pn * tstepB + (size_t)nxt.pz * g.zB : cB;
        for (int t = 0; t < nt; t += 2) {
            const bool last = (t == nt - 2);
            const char* a1 = cA + (size_t)(t + 1) * kstep;
            const char* a2 = last ? nA : cA + (size_t)(t + 2) * kstep; const char* b2 = last ? nB : cB + (size_t)(t + 2) * kstep;
            const char* a3 = a2 + kstep; const char* b3 = b2 + kstep;
            if (last && has_next) S.a_ready(nxt);
            if constexpr (SP2) {
            PG8_LDB(B0, 0, 0); PG8_LDB(B1, 0, 1); PG8_SCHED; PG8_LDA(At, 0, 0); PG8_STAGE(PG8_SA(1, 1), a1 + hstepA, voffA);
            PG8_WAIT_VK; PG8_WAIT_L(0); PG8_BAR; PG8_MMA(0, 0, At, B0); PG8_MMA(0, 1, At, B1); PG8_BAR; PG8_SCHED;
            PG8_LDA(At, 0, 1); PG8_STAGE(PG8_SB(0, 0), b2, voffB); PG8_STAGE(PG8_SB(0, 1), b2 + hstepB, voffB); PG8_STAGE(PG8_SA(0, 0), a2, voffA);
            PG8_WAIT_VK; PG8_WAIT_L(0); PG8_BAR; PG8_MMA(1, 0, At, B0); PG8_MMA(1, 1, At, B1); PG8_BAR; PG8_SCHED;
            PG8_LDB(B0, 1, 0); PG8_LDB(B1, 1, 1); PG8_SCHED; PG8_LDA(At, 1, 0); PG8_STAGE(PG8_SA(0, 1), a2 + hstepA, voffA);
            PG8_WAIT_VK; PG8_WAIT_L(0); PG8_BAR; PG8_MMA(0, 0, At, B0); PG8_MMA(0, 1, At, B1); PG8_BAR; PG8_SCHED;
            PG8_LDA(At, 1, 1); PG8_STAGE(PG8_SB(1, 0), b3, voffB); PG8_STAGE(PG8_SB(1, 1), b3 + hstepB, voffB); PG8_STAGE(PG8_SA(1, 0), a3, voffA);
            PG8_WAIT_VK; PG8_WAIT_L(0); PG8_BAR; PG8_MMA(1, 0, At, B0); PG8_MMA(1, 1, At, B1); PG8_BAR; PG8_SCHED;
            } else {
            PG8_LDB(B0, 0, 0); PG8_SCHED; PG8_LDA(At, 0, 0); PG8_STAGE(PG8_SA(1, 1), a1 + hstepA, voffA);
            PG8_WAIT_L(8); PG8_BAR; PG8_WAIT_L(0); PG8_MMA(0, 0, At, B0); PG8_BAR; PG8_SCHED;
            PG8_LDB(B1, 0, 1); PG8_STAGE(PG8_SB(0, 0), b2, voffB);
            PG8_BAR; PG8_WAIT_L(0); PG8_MMA(0, 1, At, B1); PG8_BAR;
            PG8_LDA(At, 0, 1); PG8_STAGE(PG8_SA(0, 0), a2, voffA);
            PG8_BAR; PG8_WAIT_L(0); PG8_MMA(1, 0, At, B0); PG8_BAR; PG8_SCHED;
            PG8_STAGE(PG8_SB(0, 1), b2 + hstepB, voffB);
            PG8_WAIT_V(6); PG8_BAR; PG8_MMA(1, 1, At, B1); PG8_BAR;
            PG8_LDB(B0, 1, 0); PG8_SCHED; PG8_LDA(At, 1, 0); PG8_STAGE(PG8_SA(0, 1), a2 + hstepA, voffA);
            PG8_WAIT_L(8); PG8_BAR; PG8_WAIT_L(0); PG8_MMA(0, 0, At, B0); PG8_BAR; PG8_SCHED;
            PG8_LDB(B1, 1, 1); PG8_STAGE(PG8_SB(1, 0), b3, voffB);
            PG8_BAR; PG8_WAIT_L(0); PG8_MMA(0, 1, At, B1); PG8_BAR;
            PG8_LDA(At, 1, 1); PG8_STAGE(PG8_SA(1, 0), a3, voffA);
            PG8_BAR; PG8_WAIT_L(0); PG8_MMA(1, 0, At, B0); PG8_BAR; PG8_SCHED;
            PG8_STAGE(PG8_SB(1, 1), b3 + hstepB, voffB);
            PG8_WAIT_V(6); PG8_BAR; PG8_MMA(1, 1, At, B1); PG8_BAR;
            }
        }
        if constexpr (ALIGN_EPI) { if (wr == 0) PG8_BAR; }
        if constexpr (!Epi::AFTER_DRAIN) { E(acc, cur, wr, wc, fr, fq); S.done(cur); }
        if (!has_next) break;
#pragma unroll
        for (int a = 0; a < 2; ++a)
#pragma unroll
            for (int b = 0; b < 2; ++b)
#pragma unroll
                for (int m = 0; m < 4; ++m)
#pragma unroll
                    for (int n = 0; n < 2; ++n) acc[a][b][m][n] = (f32x4){0.f, 0.f, 0.f, 0.f};
        cur = nxt; cA = nA; cB = nB; ++ui;
        if constexpr (ALIGN_EPI) { if (wr == 1) PG8_BAR; }
    }
    PG8_WAIT_V(0);
    if constexpr (!ALIGN_EPI) { if (wr == 0) PG8_BAR; }
    PG8_BAR;
    if constexpr (Epi::AFTER_DRAIN) { E.fused(acc, cur, wr, wc, fr, fq, lds, wid, lane); S.done(cur); }
#undef PG8_SA
#undef PG8_SB
#undef PG8_STAGE
#undef PG8_LDA
#undef PG8_LDB
#undef PG8_MMA
#undef PG8_WAIT_V
#undef PG8_WAIT_L
#undef PG8_BAR
#undef PG8_SCHED
}
}
#define GAS __attribute__((address_space(1)))
#define LAS __attribute__((address_space(3)))
typedef unsigned short bf16;
typedef unsigned v4u __attribute__((ext_vector_type(4)));
typedef float f32x4 __attribute__((ext_vector_type(4)));
typedef short bf16x8 __attribute__((ext_vector_type(8)));
typedef GAS unsigned gu32;
typedef GAS unsigned long long gu64;
#define RLX_AGENT __ATOMIC_RELAXED, __HIP_MEMORY_SCOPE_AGENT
#define LDS_WAIT() asm volatile("s_waitcnt lgkmcnt(0)" ::: "memory")
#define VM_WAIT() asm volatile("s_waitcnt vmcnt(0)" ::: "memory")
__device__ __forceinline__ unsigned long long rt() { return __builtin_amdgcn_s_memrealtime(); }
__device__ __forceinline__ unsigned f2bf(float f) { unsigned u = __builtin_bit_cast(unsigned, f); return (u + 0x7fffu + ((u >> 16) & 1u)) >> 16; }
__device__ __forceinline__ unsigned pk2(float lo, float hi) { return f2bf(lo) | (f2bf(hi) << 16); }

#define XB_TMO      128
#define XB_XCNT(j)  (256  + 64 * (j))
#define XB_XSUB(j)  (1280 + 64 * (j))
#define XB_XGEN(j)  (2304 + 64 * (j))
#define XB_TOP      3328
#define XB_TOPGEN   3392
#define XCD_BAR_WORDS 3456
#define XB_SPIN_CAP (1u << 18)

__device__ __forceinline__ unsigned xb_ld(unsigned* p)              { return __hip_atomic_load(p, __ATOMIC_RELAXED, __HIP_MEMORY_SCOPE_AGENT); }
__device__ __forceinline__ unsigned xb_add(unsigned* p, unsigned v) { return __hip_atomic_fetch_add(p, v, __ATOMIC_RELAXED, __HIP_MEMORY_SCOPE_AGENT); }
__device__ __forceinline__ unsigned xb_xcc_id() { return (unsigned)__builtin_amdgcn_s_getreg((3 << 11) | 20) & 0xFu; }
#define XB_SPIN(cond, bar) do { unsigned _sp = 0; while (cond) { __builtin_amdgcn_s_sleep(1); \
    if ((++_sp & 255u) == 0u) { if (xb_ld(&(bar)[XB_TMO])) break; if (_sp > XB_SPIN_CAP) { atomicAdd(&(bar)[XB_TMO], 1u); break; } } } } while (0)

struct XcdBarrier {
    unsigned* bar; unsigned x;
    volatile LAS unsigned* st;
};

__device__ __forceinline__ XcdBarrier xcd_barrier_post(unsigned* bar, volatile LAS unsigned* st) {
    XcdBarrier b; b.bar = bar; b.x = xb_xcc_id(); b.st = st;
    if (threadIdx.x == 0) (void)xb_add(&bar[XB_XCNT(b.x)], 1u);
    return b;
}
__device__ __forceinline__ void xcd_barrier_complete(unsigned* bar, unsigned x, unsigned& nloc, unsigned& nx) {
    const unsigned G = gridDim.x * gridDim.y * gridDim.z;
    unsigned sum, cnt, mine, sp = 0u;
    for (;;) {
        sum = 0u; cnt = 0u; mine = 0u;
#pragma unroll
        for (unsigned j = 0; j < 16; ++j) { const unsigned c = xb_ld(&bar[XB_XCNT(j)]); sum += c; cnt += (c > 0u) ? 1u : 0u; mine = (j == x) ? c : mine; }
        if (sum == G) break;
        __builtin_amdgcn_s_sleep(1);
        if ((++sp & 255u) == 0u) { if (xb_ld(&bar[XB_TMO])) break; if (sp > XB_SPIN_CAP) { atomicAdd(&bar[XB_TMO], 1u); break; } }
    }
    nloc = mine > 0u ? mine : 1u; nx = cnt > 0u ? cnt : 1u;
}

__device__ __forceinline__ void xcd_barrier(const XcdBarrier& b) {
    asm volatile("s_waitcnt vmcnt(0)" ::: "memory");
    __syncthreads();
    if (threadIdx.x == 0) {
        unsigned* bar = b.bar;
        __builtin_amdgcn_s_waitcnt(0);
        unsigned nloc = b.st[0], nx = b.st[1];
        if (nloc == 0u) { xcd_barrier_complete(bar, b.x, nloc, nx); b.st[0] = nloc; b.st[1] = nx; }
        const unsigned old = xb_add(&bar[XB_XSUB(b.x)], 1u);
        const unsigned gen = old / nloc;
        if (old + 1u == (gen + 1u) * nloc) {
            __builtin_amdgcn_fence(__ATOMIC_RELEASE, "agent");
            asm volatile("s_waitcnt vmcnt(0)" ::: "memory");
            const unsigned og = xb_add(&bar[XB_TOP], 1u);
            const unsigned tg = og / nx;
            if (og + 1u == (tg + 1u) * nx) xb_add(&bar[XB_TOPGEN], 1u);
            else XB_SPIN(xb_ld(&bar[XB_TOPGEN]) == tg, bar);
            __builtin_amdgcn_fence(__ATOMIC_ACQUIRE, "agent");
            xb_add(&bar[XB_XGEN(b.x)], 1u);
            asm volatile("s_waitcnt vmcnt(0)" ::: "memory");
        } else {
            XB_SPIN(xb_ld(&bar[XB_XGEN(b.x)]) == gen, bar);
            __builtin_amdgcn_fence(__ATOMIC_ACQUIRE, "agent");
            asm volatile("s_waitcnt vmcnt(0)" ::: "memory");
        }
    }
    __syncthreads();
}

#define DBG_LAYERS 4
#define DBG_SUBS 3

constexpr int DM = 2048, BATCH = 16, SEQ = 2048, DEPTH = 4, MTOK = BATCH * SEQ;
constexpr int DFF = 5632, NIN = 13400;
constexpr int PROJ_LD = 5376, NPT = 21, NWIN = 13568, GATE_LD = 8192;
constexpr float NORM_EPS = 1e-5f;
constexpr float ALPHA = 1.681792830507429f;
constexpr int PA_Q = 0, PA_K = 512, PA_V = 1024, PB_Q = 1536, PB_K = 1792, PB_V = 2048, PB_R = 2560, PC_Q = 3072, PC_KV = 3456, PD_Z = 3584, PD_XBC = 4096, PC_KR = 5120, PB_GLOW = 5184, PD_DT = 5200;
constexpr size_t MiB = 1u << 20;
constexpr size_t WS_CTL = 0, CTL_ZERO_BYTES = 1 * MiB;
constexpr size_t WS_ROPE = 1 * MiB;
constexpr size_t WS_WGU0 = 11 * MiB, WS_WD0 = 55 * MiB, WS_WGU1 = 77 * MiB, WS_WD1 = 121 * MiB, WS_WIN = 143 * MiB, WS_WB = 196 * MiB, WS_WO = 204 * MiB, WS_WUQ = 212 * MiB, WS_WUKV = 213 * MiB;
constexpr size_t WS_HB = 214 * MiB;
constexpr size_t WS_MIX = 342 * MiB;
constexpr size_t WS_ACT = WS_MIX;
constexpr size_t WS_PROJ = WS_MIX;
constexpr size_t WS_MERGED = WS_MIX;
constexpr size_t WS_GATES = WS_MIX + 336 * MiB;
constexpr size_t WS_OBR = WS_GATES + 512 * MiB;
constexpr size_t WS_QM = WS_OBR + 128 * MiB;
constexpr size_t WS_KVM = WS_QM + 48 * MiB;
constexpr size_t WS_CQN = WS_KVM + 64 * MiB;
constexpr size_t WS_CKVN = WS_CQN + 24 * MiB;
constexpr size_t WS_KROPE = WS_CKVN + 16 * MiB;
constexpr size_t WS_XBC = WS_KROPE + 4 * MiB;
constexpr size_t WS_DT = WS_XBC + 64 * MiB;
constexpr size_t WS_RAWA = WS_DT + 1 * MiB;
constexpr size_t WS_RAWB = WS_RAWA + 128 * MiB;
constexpr size_t WS_RAWD = WS_RAWB + 64 * MiB;
constexpr size_t WS_END = WS_RAWD + 64 * MiB;
static_assert(WS_END <= 1956000000ull, "workspace");
static_assert(WS_WD0 - WS_WGU0 >= (size_t)11264 * 2048 * 2 && WS_WGU1 - WS_WD0 >= (size_t)2048 * 5632 * 2 && WS_WB - WS_WIN >= (size_t)NWIN * 2048 * 2 && WS_WO - WS_WB >= (size_t)4 * 2048 * 512 * 2, "weights map");
constexpr int CW_BAR = 4096;
constexpr int LDS_BYTES = 147456, MISC_OFF = 131072 + 320;

struct Params {
    const float* x; const int* pos; const float* ln_g; const float* ln_b;
    const float* w_gu[2]; const float* w_down[2]; const float* w_in; const float* b_gate;
    const float* diff_lambda; const float* diff_subln_g; const float* gla_w_gate2; const float* gla_b_gate; const float* gla_norm_g;
    const float* mla_q_norm_g; const float* mla_w_uq; const float* mla_kv_norm_g; const float* mla_w_ukv;
    const float* ssd_conv_w; const float* ssd_conv_b; const float* ssd_dt_bias; const float* ssd_a_log; const float* ssd_d; const float* ssd_norm_g;
    const float* w_branch; const float* w_out;
    float* out; unsigned char* ws;
    float lam_init[4]; float inv_d[8]; float inv_m[32];
};
typedef const __attribute__((address_space(4))) Params& PRM;
struct Ctx { LAS unsigned char* lds; int tid, lane, wave, G, bid; };

__device__ __forceinline__ float bf2f(bf16 v) { return __uint_as_float(((unsigned)v) << 16); }
__device__ __forceinline__ float wave_sum(float v) {
#pragma unroll
    for (int o = 1; o < 64; o <<= 1) v += __shfl_xor(v, o);
    return v;
}
__device__ __forceinline__ float silu_f(float x) { return x / (1.0f + __expf(-x)); }
__device__ __forceinline__ float softplus_f(float x) { return fmaxf(x, 0.f) + log1pf(__expf(-fabsf(x))); }
__device__ __forceinline__ float logsigmoid_f(float x) { return fminf(x, 0.f) - log1pf(__expf(-fabsf(x))); }

__device__ __forceinline__ int src_col(int kind, int d) {
    if (kind == 0) { const int t = d >> 8, w = d & 255; return w < 128 ? t * 128 + w : DFF + t * 128 + (w - 128); }
    if (kind == 2) {
        if (d < 2560) return d;
        if (d < 3072) return 2576 + (d - 2560);
        if (d < 3456) return 3088 + (d - 3072);
        if (d < 3584) return 3472 + (d - 3456);
        if (d < 4096) return 3664 + (d - 3584);
        if (d < 5120) return 4176 + (d - 4096);
        if (d < 5184) return 3600 + (d - 5120);
        if (d < 5200) return 2560 + (d - 5184);
        if (d < 5208) return 5200 + (d - 5200);
        if (d < 5376) return -1;
        return 5208 + (d - 5376);
    }
    return d;
}
__device__ __forceinline__ void transpose_item(const float* W, int K, int N, bf16* WT, int ldw, LAS float* scr, int rb, int kb, int lane, int kind) {
    const int k0 = 64 * kb, src = src_col(kind, rb * 32 + (lane & 31));
#pragma unroll 8
    for (int i = 0; i < 32; ++i) { const int kk = 2 * i + (lane >> 5); float v = 0.f; if (src >= 0 && k0 + kk < K) v = W[(size_t)(k0 + kk) * N + src]; scr[kk * 33 + (lane & 31)] = v; }
    LDS_WAIT(); asm volatile("" ::: "memory");
    const int c = lane & 7;
#pragma unroll
    for (int j = 0; j < 4; ++j) { const int n = (lane >> 3) + 8 * j; const LAS float* s = scr + (8 * c) * 33 + n;
        v4u o; o.x = pk2(s[0 * 33], s[1 * 33]); o.y = pk2(s[2 * 33], s[3 * 33]); o.z = pk2(s[4 * 33], s[5 * 33]); o.w = pk2(s[6 * 33], s[7 * 33]);
        *(GAS v4u*)(WT + (size_t)(rb * 32 + n) * ldw + k0 + 8 * c) = o; }
    LDS_WAIT(); asm volatile("" ::: "memory");
}
__device__ __forceinline__ void ph_convert(PRM p, Ctx& c, int layer) {
    LAS float* scr = (LAS float*)(c.lds + c.wave * 16384);
    const int gw = c.bid * 8 + c.wave, NGW = c.G * 8;
    unsigned char* ws = p.ws;
    constexpr int I_GU = (11264 / 32) * (2048 / 64), I_DN = (2048 / 32) * (5632 / 64), I_WIN = (NWIN / 32) * 32, I_WB1 = 64 * 8, I_WO = 64 * 32, I_UQ = 24 * 6, I_UKV = 32 * 4;
    constexpr int TOT = 2 * (I_GU + I_DN) + I_WIN + 4 * I_WB1 + I_WO + I_UQ + I_UKV;
    for (int it = gw; it < TOT; it += NGW) {
        int r = it;
        if (r < 2 * I_GU) { const int f = r / I_GU; r -= f * I_GU; transpose_item(p.w_gu[f] + (size_t)layer * 2048 * 11264, 2048, 11264, (bf16*)(ws + (f ? WS_WGU1 : WS_WGU0)), 2048, scr, r / 32, r % 32, c.lane, 0); continue; } r -= 2 * I_GU;
        if (r < 2 * I_DN) { const int f = r / I_DN; r -= f * I_DN; transpose_item(p.w_down[f] + (size_t)layer * 5632 * 2048, 5632, 2048, (bf16*)(ws + (f ? WS_WD1 : WS_WD0)), 5632, scr, r / 88, r % 88, c.lane, 1); continue; } r -= 2 * I_DN;
        if (r < I_WIN) { transpose_item(p.w_in + (size_t)layer * 2048 * NIN, 2048, NIN, (bf16*)(ws + WS_WIN), 2048, scr, r / 32, r % 32, c.lane, 2); continue; } r -= I_WIN;
        if (r < 4 * I_WB1) { const int z = r / I_WB1; r -= z * I_WB1; transpose_item(p.w_branch + (size_t)(layer * 4 + z) * 512 * 2048, 512, 2048, (bf16*)(ws + WS_WB) + (size_t)z * 2048 * 512, 512, scr, r / 8, r % 8, c.lane, 1); continue; } r -= 4 * I_WB1;
        if (r < I_WO) { transpose_item(p.w_out + (size_t)layer * 2048 * 2048, 2048, 2048, (bf16*)(ws + WS_WO), 2048, scr, r / 32, r % 32, c.lane, 1); continue; } r -= I_WO;
        if (r < I_UQ) { transpose_item(p.mla_w_uq + (size_t)layer * 384 * 768, 384, 768, (bf16*)(ws + WS_WUQ), 384, scr, r / 6, r % 6, c.lane, 1); continue; } r -= I_UQ;
        transpose_item(p.mla_w_ukv + (size_t)layer * 128 * 1024, 128, 1024, (bf16*)(ws + WS_WUKV), 256, scr, r / 4, r % 4, c.lane, 1);
    }
    if (layer == 0) {
        const size_t n8 = (size_t)MTOK * DM / 8; bf16* hb = (bf16*)(ws + WS_HB);
        for (size_t i = (size_t)c.bid * 512 + c.tid; i < n8; i += (size_t)c.G * 512) {
            const f32x4 a = *(const GAS f32x4*)(p.x + i * 8), b = *(const GAS f32x4*)(p.x + i * 8 + 4);
            v4u o; o.x = pk2(a.x, a.y); o.y = pk2(a.z, a.w); o.z = pk2(b.x, b.y); o.w = pk2(b.z, b.w);
            *(GAS v4u*)(hb + i * 8) = o; }
        float* cosd = (float*)(ws + WS_ROPE); float* sind = cosd + (size_t)MTOK * 8; float* cosm = sind + (size_t)MTOK * 8; float* sinm = cosm + (size_t)MTOK * 32;
        for (int i = c.bid * 512 + c.tid; i < MTOK * 40; i += c.G * 512) {
            const int row = i / 40, j = i % 40; const float ps = (float)p.pos[row];
            float sn, cs;
            if (j < 8) { const float ang = ps * p.inv_d[j]; sincosf(ang, &sn, &cs); cosd[row * 8 + j] = cs; sind[row * 8 + j] = sn; }
            else { const float ang = ps * p.inv_m[j - 8]; sincosf(ang, &sn, &cs); cosm[row * 32 + j - 8] = cs; sinm[row * 32 + j - 8] = sn; }
        }
    }
}

__device__ __forceinline__ void ph_ln(PRM p, Ctx& c, int layer, int sub) {
    const float* g = p.ln_g + (size_t)(layer * 3 + sub) * DM; const float* bb = p.ln_b + (size_t)(layer * 3 + sub) * DM;
    bf16* hb = (bf16*)(p.ws + WS_HB);
    const int gw = c.bid * 8 + c.wave, NGW = c.G * 8;
    f32x4 gv[8], bv[8];
#pragma unroll
    for (int j = 0; j < 8; ++j) { gv[j] = *(const GAS f32x4*)(g + j * 256 + c.lane * 4); bv[j] = *(const GAS f32x4*)(bb + j * 256 + c.lane * 4); }
    for (int row = gw; row < MTOK; row += NGW) {
        float* hr = p.out + (size_t)row * DM;
        f32x4 v[8]; float s = 0.f;
#pragma unroll
        for (int j = 0; j < 8; ++j) { v[j] = *(const GAS f32x4*)(hr + j * 256 + c.lane * 4); s += (v[j].x + v[j].y) + (v[j].z + v[j].w); }
        const float mean = wave_sum(s) * (1.f / DM); float s2 = 0.f;
#pragma unroll
        for (int j = 0; j < 8; ++j) { v[j] = v[j] - mean; s2 += (v[j].x * v[j].x + v[j].y * v[j].y) + (v[j].z * v[j].z + v[j].w * v[j].w); }
        const float rstd = 1.0f / sqrtf(wave_sum(s2) * (1.f / DM) + NORM_EPS);
#pragma unroll
        for (int j = 0; j < 8; ++j) { const f32x4 o = v[j] * rstd * gv[j] + bv[j]; *(GAS f32x4*)(hr + j * 256 + c.lane * 4) = o;
            *(GAS unsigned long long*)(hb + (size_t)row * DM + j * 256 + c.lane * 4) = (unsigned long long)pk2(o.x, o.y) | ((unsigned long long)pk2(o.z, o.w) << 32); }
    }
}

__device__ __forceinline__ void ph_prep(PRM p, Ctx& c, int layer) {
    const bf16* proj = (const bf16*)(p.ws + WS_PROJ);
    bf16* cqn = (bf16*)(p.ws + WS_CQN); bf16* ckvn = (bf16*)(p.ws + WS_CKVN); bf16* krope = (bf16*)(p.ws + WS_KROPE); bf16* xbc = (bf16*)(p.ws + WS_XBC); float* dt = (float*)(p.ws + WS_DT);
    const float* cosm = (const float*)(p.ws + WS_ROPE) + (size_t)MTOK * 16; const float* sinm = cosm + (size_t)MTOK * 32;
    const float* qg = p.mla_q_norm_g + layer * 384; const float* kvg = p.mla_kv_norm_g + layer * 128;
    const float* cw = p.ssd_conv_w + layer * 4 * 1024; const float* cb = p.ssd_conv_b + layer * 1024; const float* dtb = p.ssd_dt_bias + layer * 8;
    const int gw = c.bid * 8 + c.wave, NGW = c.G * 8, lane = c.lane;
    for (int row = gw; row < MTOK; row += NGW) {
        const bf16* pr = proj + (size_t)row * PROJ_LD;
        { float v[6]; float ss = 0.f;
#pragma unroll
          for (int j = 0; j < 6; ++j) { v[j] = bf2f(pr[PC_Q + lane + 64 * j]); ss += v[j] * v[j]; }
          const float rs = 1.0f / sqrtf(wave_sum(ss) * (1.f / 384.f) + NORM_EPS);
#pragma unroll
          for (int j = 0; j < 6; ++j) cqn[(size_t)row * 384 + lane + 64 * j] = (bf16)f2bf(v[j] * rs * qg[lane + 64 * j]); }
        { float v0 = bf2f(pr[PC_KV + lane]), v1 = bf2f(pr[PC_KV + 64 + lane]);
          const float rs = 1.0f / sqrtf(wave_sum(v0 * v0 + v1 * v1) * (1.f / 128.f) + NORM_EPS);
          bf16* o = ckvn + (size_t)row * 256; o[lane] = (bf16)f2bf(v0 * rs * kvg[lane]); o[64 + lane] = (bf16)f2bf(v1 * rs * kvg[64 + lane]); o[128 + lane] = 0; o[192 + lane] = 0; }
        if (lane < 32) { const float x1 = bf2f(pr[PC_KR + lane]), x2 = bf2f(pr[PC_KR + 32 + lane]); const float cs = cosm[(size_t)row * 32 + lane], sn = sinm[(size_t)row * 32 + lane];
          krope[(size_t)row * 64 + lane] = (bf16)f2bf(x1 * cs - x2 * sn); krope[(size_t)row * 64 + 32 + lane] = (bf16)f2bf(x1 * sn + x2 * cs); }
        { const int t = row & (SEQ - 1);
#pragma unroll 4
          for (int j = 0; j < 16; ++j) { const int ch = lane + 64 * j; float a = cb[ch];
#pragma unroll
            for (int k = 0; k < 4; ++k) { const int tt = t - 3 + k; if (tt >= 0) a += cw[k * 1024 + ch] * bf2f(proj[(size_t)(row - 3 + k) * PROJ_LD + PD_XBC + ch]); }
            xbc[(size_t)row * 1024 + ch] = (bf16)f2bf(silu_f(a)); } }
        if (lane < 8) dt[(size_t)row * 8 + lane] = softplus_f(bf2f(pr[PD_DT + lane]) + dtb[lane]);
    }
}

template <int DK, bool MLA>
__device__ __forceinline__ void attn_naive_item(PRM p, Ctx& c, int inst, int qb) {
    const bf16* proj = (const bf16*)(p.ws + WS_PROJ); const bf16* qm = (const bf16*)(p.ws + WS_QM); const bf16* kvm = (const bf16*)(p.ws + WS_KVM); const bf16* krope = (const bf16*)(p.ws + WS_KROPE);
    const float* cosd = (const float*)(p.ws + WS_ROPE); const float* sind = cosd + (size_t)MTOK * 8; const float* cosm = sind + (size_t)MTOK * 8; const float* sinm = cosm + (size_t)MTOK * 32;
    const int r = c.tid >> 3, part = c.tid & 7;
    int b, h, m = 0; if (MLA) { b = inst >> 2; h = inst & 3; } else { m = inst & 1; h = (inst >> 1) & 3; b = inst >> 3; }
    const size_t rowbase = (size_t)b * SEQ; const size_t qrow = rowbase + qb * 64 + r;
    const float scale = MLA ? 0.07216878364870322f : 0.125f;
    float q[DK / 8];
    if (MLA) {
#pragma unroll
        for (int i = 0; i < DK / 8; ++i) q[i] = bf2f(qm[qrow * 768 + h * 192 + part + 8 * i]);
#pragma unroll
        for (int t = 0; t < 4; ++t) { const float x1 = q[16 + t], x2 = q[20 + t]; const float cs = cosm[qrow * 32 + part + 8 * t], sn = sinm[qrow * 32 + part + 8 * t]; q[16 + t] = x1 * cs - x2 * sn; q[20 + t] = x1 * sn + x2 * cs; }
    } else {
#pragma unroll
        for (int i = 0; i < DK / 8; ++i) q[i] = bf2f(proj[qrow * PROJ_LD + PA_Q + h * 128 + m * 64 + part + 8 * i]);
        const float x1 = q[0], x2 = q[1]; const float cs = cosd[qrow * 8 + part], sn = sind[qrow * 8 + part]; q[0] = x1 * cs - x2 * sn; q[1] = x1 * sn + x2 * cs;
    }
#pragma unroll
    for (int i = 0; i < DK / 8; ++i) q[i] *= scale;
    float o[16]; float mx = -INFINITY, l = 0.f;
#pragma unroll
    for (int i = 0; i < 16; ++i) o[i] = 0.f;
    LAS float* Ks = (LAS float*)c.lds; LAS float* Vs = Ks + 64 * DK;
    for (int kt = 0; kt <= qb; ++kt) {
        __syncthreads();
        for (int e = c.tid; e < 64 * DK; e += 512) { const int j = e / DK, d = e % DK; const size_t krow = rowbase + kt * 64 + j; float v;
            if (MLA) { v = d < 128 ? bf2f(kvm[krow * 1024 + h * 256 + d]) : bf2f(krope[krow * 64 + d - 128]); }
            else { const bf16* kb = proj + krow * PROJ_LD + PA_K + h * 128 + m * 64;
                if (d >= 16) v = bf2f(kb[d]); else { const int i = d & 7; const float x1 = bf2f(kb[i]), x2 = bf2f(kb[i + 8]); const float cs = cosd[krow * 8 + i], sn = sind[krow * 8 + i]; v = d < 8 ? x1 * cs - x2 * sn : x1 * sn + x2 * cs; } }
            Ks[e] = v; }
        for (int e = c.tid; e < 64 * 128; e += 512) { const int j = e >> 7, d = e & 127; const size_t krow = rowbase + kt * 64 + j;
            Vs[e] = MLA ? bf2f(kvm[krow * 1024 + h * 256 + 128 + d]) : bf2f(proj[krow * PROJ_LD + PA_V + h * 128 + d]); }
        __syncthreads();
        const int jmax = (kt == qb) ? r : 63;
        for (int j = 0; j < 64; ++j) {
            float s = 0.f;
#pragma unroll
            for (int i = 0; i < DK / 8; ++i) s += q[i] * Ks[j * DK + part + 8 * i];
            s += __shfl_xor(s, 1); s += __shfl_xor(s, 2); s += __shfl_xor(s, 4);
            if (j <= jmax) {
                if (s > mx) { const float f = __expf(mx - s); l *= f;
#pragma unroll
                    for (int i = 0; i < 16; ++i) o[i] *= f;
                    mx = s; }
                const float pe = __expf(s - mx); l += pe;
#pragma unroll
                for (int i = 0; i < 16; ++i) o[i] += pe * Vs[j * 128 + part * 16 + i];
            }
        }
    }
    const float inv = 1.0f / l;
    if (MLA) { bf16* ob = (bf16*)(p.ws + WS_OBR) + qrow * 2048 + 1024 + h * 128 + part * 16;
#pragma unroll
        for (int i = 0; i < 16; ++i) ob[i] = (bf16)f2bf(o[i] * inv); }
    else { float* ra = (float*)(p.ws + WS_RAWA) + ((size_t)m * MTOK + qrow) * 512 + h * 128 + part * 16;
#pragma unroll
        for (int i = 0; i < 16; ++i) ra[i] = o[i] * inv; }
}
__device__ __forceinline__ void gla_naive_item(PRM p, Ctx& c, int layer, int inst) {
    const bf16* proj = (const bf16*)(p.ws + WS_PROJ); float* rawb = (float*)(p.ws + WS_RAWB);
    const float* w2 = p.gla_w_gate2 + layer * 16 * 256; const float* b2 = p.gla_b_gate + layer * 256;
    const int b = inst >> 2, h = inst & 3; const size_t rowbase = (size_t)b * SEQ;
    LAS float* Qs = (LAS float*)c.lds; LAS float* Ks = Qs + 64 * 64; LAS float* Es = Ks + 64 * 64;
    float S[64];
#pragma unroll
    for (int i = 0; i < 64; ++i) S[i] = 0.f;
    for (int ch = 0; ch < SEQ / 64; ++ch) {
        __syncthreads();
        for (int e = c.tid; e < 64 * 64; e += 512) { const int t = e >> 6, d = e & 63; const bf16* pr = proj + (rowbase + ch * 64 + t) * PROJ_LD;
            Qs[e] = bf2f(pr[PB_Q + h * 64 + d]) * 0.125f; Ks[e] = bf2f(pr[PB_K + h * 64 + d]);
            float a = b2[h * 64 + d];
#pragma unroll
            for (int r = 0; r < 16; ++r) a += bf2f(pr[PB_GLOW + r]) * w2[r * 256 + h * 64 + d];
            Es[e] = __expf(logsigmoid_f(a) * (1.f / 16.f)); }
        __syncthreads();
        if (c.tid < 128) {
            for (int t = 0; t < 64; ++t) { const size_t row = rowbase + ch * 64 + t; const float v = bf2f(proj[row * PROJ_LD + PB_V + h * 128 + c.tid]); float o = 0.f;
#pragma unroll
                for (int d = 0; d < 64; ++d) { S[d] = Es[t * 64 + d] * S[d] + Ks[t * 64 + d] * v; o += Qs[t * 64 + d] * S[d]; }
                rawb[row * 512 + h * 128 + c.tid] = o; }
        }
    }
}
__device__ __forceinline__ void ssd_naive_item(PRM p, Ctx& c, int layer, int b) {
    const bf16* xbc = (const bf16*)(p.ws + WS_XBC); const float* dt = (const float*)(p.ws + WS_DT); float* rawd = (float*)(p.ws + WS_RAWD);
    const int hd = c.wave, g = hd >> 2, lane = c.lane; const size_t rowbase = (size_t)b * SEQ;
    const float a = -__expf(p.ssd_a_log[layer * 8 + hd]), dsk = p.ssd_d[layer * 8 + hd];
    LAS float* Bs = (LAS float*)c.lds; LAS float* Cs = Bs + 32 * 256;
    float hs[128];
#pragma unroll
    for (int i = 0; i < 128; ++i) hs[i] = 0.f;
    for (int ch = 0; ch < SEQ / 32; ++ch) {
        __syncthreads();
        for (int e = c.tid; e < 32 * 256; e += 512) { const int t = e >> 8, n = e & 255; const bf16* xr = xbc + (rowbase + ch * 32 + t) * 1024; Bs[e] = bf2f(xr[512 + n]); Cs[e] = bf2f(xr[768 + n]); }
        __syncthreads();
        for (int t = 0; t < 32; ++t) { const size_t row = rowbase + ch * 32 + t; const float x = bf2f(xbc[row * 1024 + hd * 64 + lane]); const float dtv = dt[row * 8 + hd];
            const float dec = __expf(dtv * a), xdt = x * dtv; float y = 0.f;
#pragma unroll
            for (int n = 0; n < 128; ++n) { hs[n] = hs[n] * dec + xdt * Bs[t * 256 + g * 128 + n]; y += Cs[t * 256 + g * 128 + n] * hs[n]; }
            rawd[row * 512 + hd * 64 + lane] = y + dsk * x; }
    }
}
__device__ __forceinline__ void ph_mix_naive(PRM p, Ctx& c, int layer) {
#ifdef DBG_MIX_FAKE
    { const bf16* proj = (const bf16*)(p.ws + WS_PROJ); float* rawa = (float*)(p.ws + WS_RAWA); float* rawb = (float*)(p.ws + WS_RAWB); float* rawd = (float*)(p.ws + WS_RAWD); bf16* obr = (bf16*)(p.ws + WS_OBR);
      for (size_t i = (size_t)c.bid * 512 + c.tid; i < (size_t)MTOK * 512; i += (size_t)c.G * 512) { const size_t row = i >> 9; const int col = (int)(i & 511);
          const float v = bf2f(proj[row * PROJ_LD + PA_V + col]);
          rawa[i] = v; rawa[(size_t)MTOK * 512 + i] = 0.5f * v; rawb[i] = bf2f(proj[row * PROJ_LD + PB_V + col]); rawd[i] = bf2f(proj[row * PROJ_LD + PD_Z + col]); obr[row * 2048 + 1024 + col] = proj[row * PROJ_LD + PC_Q + (col % 384)]; }
      return; }
#endif
    if (c.bid < 64) gla_naive_item(p, c, layer, c.bid);
    else if (c.bid < 80) ssd_naive_item(p, c, layer, c.bid - 64);
    for (int it = c.bid; it < 6144; it += c.G) {
        const int qb = 31 - it / 192, j = it % 192;
        if (j < 128) attn_naive_item<64, false>(p, c, j, qb); else attn_naive_item<192, true>(p, c, j - 128, qb);
    }
}

__device__ __forceinline__ void ph_post(PRM p, Ctx& c, int layer) {
    const bf16* proj = (const bf16*)(p.ws + WS_PROJ); bf16* obr = (bf16*)(p.ws + WS_OBR);
    const float* rawa = (const float*)(p.ws + WS_RAWA); const float* rawb = (const float*)(p.ws + WS_RAWB); const float* rawd = (const float*)(p.ws + WS_RAWD);
    const int lane = c.lane, gw = c.bid * 8 + c.wave, NGW = c.G * 8;
    const float* lp = p.diff_lambda + layer * 256;
    float l01 = 0.f, l23 = 0.f; { l01 = lp[lane] * lp[64 + lane]; l23 = lp[128 + lane] * lp[192 + lane]; }
    const float lam_init = p.lam_init[layer];
    const float lam = __expf(wave_sum(l01)) - __expf(wave_sum(l23)) + lam_init;
    const float* sg = p.diff_subln_g + layer * 128; const float* gg = p.gla_norm_g + layer * 128; const float* ng = p.ssd_norm_g + layer * 512;
    for (int row = gw; row < MTOK; row += NGW) {
        const bf16* pr = proj + (size_t)row * PROJ_LD; bf16* orow = obr + (size_t)row * 2048;
#pragma unroll
        for (int h = 0; h < 4; ++h) { const size_t o0 = (size_t)row * 512 + h * 128, o1 = ((size_t)MTOK + row) * 512 + h * 128;
            const float a0 = rawa[o0 + lane] - lam * rawa[o1 + lane], a1 = rawa[o0 + 64 + lane] - lam * rawa[o1 + 64 + lane];
            const float rs = 1.0f / sqrtf(wave_sum(a0 * a0 + a1 * a1) * (1.f / 128.f) + NORM_EPS) * (1.0f - lam_init);
            orow[h * 128 + lane] = (bf16)f2bf(a0 * rs * sg[lane]); orow[h * 128 + 64 + lane] = (bf16)f2bf(a1 * rs * sg[64 + lane]); }
#pragma unroll
        for (int h = 0; h < 4; ++h) { const size_t o0 = (size_t)row * 512 + h * 128;
            const float a0 = rawb[o0 + lane], a1 = rawb[o0 + 64 + lane];
            const float rs = 1.0f / sqrtf(wave_sum(a0 * a0 + a1 * a1) * (1.f / 128.f) + NORM_EPS);
            const float r0 = bf2f(pr[PB_R + h * 128 + lane]), r1 = bf2f(pr[PB_R + h * 128 + 64 + lane]);
            orow[512 + h * 128 + lane] = (bf16)f2bf(a0 * rs * gg[lane] * silu_f(r0)); orow[512 + h * 128 + 64 + lane] = (bf16)f2bf(a1 * rs * gg[64 + lane] * silu_f(r1)); }
#pragma unroll
        for (int g = 0; g < 2; ++g) { float v[4]; float ss = 0.f;
#pragma unroll
            for (int j = 0; j < 4; ++j) { const int ch = g * 256 + j * 64 + lane; v[j] = rawd[(size_t)row * 512 + ch] * silu_f(bf2f(pr[PD_Z + ch])); ss += v[j] * v[j]; }
            const float rs = 1.0f / sqrtf(wave_sum(ss) * (1.f / 256.f) + NORM_EPS);
#pragma unroll
            for (int j = 0; j < 4; ++j) { const int ch = g * 256 + j * 64 + lane; orow[1536 + ch] = (bf16)f2bf(v[j] * rs * ng[ch]); } }
    }
}

__device__ __forceinline__ void ph_gu(PRM p, Ctx& c, int f) {
    pg8::Gemm g{(const bf16*)(p.ws + WS_HB), (const bf16*)(p.ws + (f ? WS_WGU1 : WS_WGU0)), MTOK, 2 * DFF, DM, DM, DM, 0, 0};
    pg8::StaticOrder S; S.init(MTOK, 2 * DFF, c.G, c.bid);
    pg8::EpiSwiglu E{(bf16*)(p.ws + WS_ACT), DFF, nullptr};
    pg8::gemm_phase<pg8::EpiSwiglu, pg8::StaticOrder, true, true>(c.lds, g, S, E);
}
__device__ __forceinline__ void ph_down(PRM p, Ctx& c, int layer, int f) {
#ifdef DBG_GU_CHECK
    { pg8::Gemm g{(const bf16*)(p.ws + WS_HB), (const bf16*)(p.ws + (f ? WS_WGU1 : WS_WGU0)), MTOK, 2 * DFF, DM, DM, DM, 0, 0};
      pg8::StaticOrder S; S.init(MTOK, 2 * DFF, c.G, c.bid);
      pg8::EpiSwiglu E{(bf16*)(p.ws + WS_ACT), DFF, (float*)(p.ws + WS_ACT)};
      pg8::gemm_phase<pg8::EpiSwiglu, pg8::StaticOrder, true, true>(c.lds, g, S, E); }
#endif
    pg8::Gemm g{(const bf16*)(p.ws + WS_ACT), (const bf16*)(p.ws + (f ? WS_WD1 : WS_WD0)), MTOK, DM, DFF, DFF, DFF, 0, 0};
    pg8::StaticOrder S; S.init(MTOK, DM, c.G, c.bid);
    pg8::EpiResidual E{(layer == 0 && f == 0) ? p.x : p.out, p.out, DM, ALPHA, 0.5f};
    pg8::gemm_phase<pg8::EpiResidual, pg8::StaticOrder, true, true>(c.lds, g, S, E);
}
__device__ __forceinline__ void ph_win(PRM p, Ctx& c, int layer) {
#ifdef DBG_WIN_FAKE
    { const bf16* hb = (const bf16*)(p.ws + WS_HB); bf16* proj = (bf16*)(p.ws + WS_PROJ); bf16* gates = (bf16*)(p.ws + WS_GATES);
      for (size_t i = (size_t)c.bid * 512 + c.tid; i < (size_t)MTOK * PROJ_LD; i += (size_t)c.G * 512) { const size_t row = i / PROJ_LD; const int col = (int)(i % PROJ_LD); proj[i] = (bf16)f2bf(0.5f * bf2f(hb[row * DM + (col & 2047)])); }
      for (size_t i = (size_t)c.bid * 512 + c.tid; i < (size_t)MTOK * GATE_LD; i += (size_t)c.G * 512) { const size_t row = i >> 13; const int col = (int)(i & 8191); gates[i] = (bf16)f2bf(pg8::fsigmoid(bf2f(hb[row * DM + (col & 2047)]))); }
      return; }
#endif
    pg8::Gemm g{(const bf16*)(p.ws + WS_HB), (const bf16*)(p.ws + WS_WIN), MTOK, NWIN, DM, DM, DM, 0, 0};
    pg8::StaticOrder S; S.init(MTOK, NWIN, c.G, c.bid);
    pg8::EpiWin E{(bf16*)(p.ws + WS_PROJ), PROJ_LD, NPT, (bf16*)(p.ws + WS_GATES), GATE_LD, p.b_gate + (size_t)layer * GATE_LD, nullptr};
    pg8::gemm_phase<pg8::EpiWin, pg8::StaticOrder, true, true>(c.lds, g, S, E);
}
__device__ __forceinline__ void ph_up(PRM p, Ctx& c) {
#ifdef DBG_WIN_CHECK
    { pg8::Gemm g{(const bf16*)(p.ws + WS_HB), (const bf16*)(p.ws + WS_WIN), MTOK, NWIN, DM, DM, DM, 0, 0};
      pg8::StaticOrder S; S.init(MTOK, NWIN, c.G, c.bid);
      pg8::EpiWin E{(bf16*)(p.ws + WS_PROJ), PROJ_LD, NPT, (bf16*)(p.ws + WS_GATES), GATE_LD, p.b_gate, p.out};
      pg8::gemm_phase<pg8::EpiWin, pg8::StaticOrder, true, true>(c.lds, g, S, E); return; }
#endif
    { pg8::Gemm g{(const bf16*)(p.ws + WS_CQN), (const bf16*)(p.ws + WS_WUQ), MTOK, 768, 384, 384, 384, 0, 0};
      pg8::StaticOrder S; S.init(MTOK, 768, c.G, c.bid);
      pg8::EpiBf16 E{(bf16*)(p.ws + WS_QM), 768};
      pg8::gemm_phase<pg8::EpiBf16, pg8::StaticOrder, true, true>(c.lds, g, S, E); }
    { pg8::Gemm g{(const bf16*)(p.ws + WS_CKVN), (const bf16*)(p.ws + WS_WUKV), MTOK, 1024, 256, 256, 256, 0, 0};
      pg8::StaticOrder S; S.init(MTOK, 1024, c.G, c.bid);
      pg8::EpiBf16 E{(bf16*)(p.ws + WS_KVM), 1024};
      pg8::gemm_phase<pg8::EpiBf16, pg8::StaticOrder, true, true>(c.lds, g, S, E); }
}
__device__ __forceinline__ void ph_merge(PRM p, Ctx& c) {
#ifdef DBG_MERGE_FAKE
    { const bf16* obr = (const bf16*)(p.ws + WS_OBR); const bf16* gates = (const bf16*)(p.ws + WS_GATES); bf16* merged = (bf16*)(p.ws + WS_MERGED);
      for (size_t i = (size_t)c.bid * 512 + c.tid; i < (size_t)MTOK * DM; i += (size_t)c.G * 512) { const size_t row = i >> 11; const int col = (int)(i & 2047);
          merged[i] = (bf16)f2bf(bf2f(gates[row * GATE_LD + col]) * bf2f(obr[i]) + bf2f(gates[row * GATE_LD + 6144 + col])); }
      return; }
#endif
    pg8::Gemm g{(const bf16*)(p.ws + WS_OBR), (const bf16*)(p.ws + WS_WB), MTOK, DM, 512, DM, 512, (size_t)512 * 2, (size_t)DM * 512 * 2};
    pg8::StaticOrder S; S.init(MTOK, DM, c.G, c.bid, 4);
    pg8::EpiMerge E{(bf16*)(p.ws + WS_MERGED), DM, (const bf16*)(p.ws + WS_GATES), GATE_LD};
    pg8::gemm_phase<pg8::EpiMerge, pg8::StaticOrder, true, true>(c.lds, g, S, E);
}
__device__ __forceinline__ void ph_wout(PRM p, Ctx& c) {
    pg8::Gemm g{(const bf16*)(p.ws + WS_MERGED), (const bf16*)(p.ws + WS_WO), MTOK, DM, DM, DM, DM, 0, 0};
    pg8::StaticOrder S; S.init(MTOK, DM, c.G, c.bid);
    pg8::EpiResidual E{p.out, p.out, DM, ALPHA, 1.0f};
    pg8::gemm_phase<pg8::EpiResidual, pg8::StaticOrder, true, true>(c.lds, g, S, E);
}

enum { PH_CONVERT = 0, PH_GU, PH_DOWN, PH_LN, PH_WIN, PH_PREP, PH_UP, PH_MIX, PH_POST, PH_MERGE, PH_WOUT, PH_COUNT };
template <int PH> __device__ __forceinline__ void run_phase(PRM p, Ctx& c0, int layer, int sub) {
    Ctx c = c0; asm volatile("" : "+v"(c.tid), "+v"(c.lane));
    if constexpr (PH == PH_CONVERT) ph_convert(p, c, layer);
    if constexpr (PH == PH_GU) ph_gu(p, c, sub >> 1);
    if constexpr (PH == PH_DOWN) ph_down(p, c, layer, sub >> 1);
    if constexpr (PH == PH_LN) ph_ln(p, c, layer, sub);
    if constexpr (PH == PH_WIN) ph_win(p, c, layer);
    if constexpr (PH == PH_PREP) ph_prep(p, c, layer);
    if constexpr (PH == PH_UP) ph_up(p, c);
    if constexpr (PH == PH_MIX) ph_mix_naive(p, c, layer);
    if constexpr (PH == PH_POST) ph_post(p, c, layer);
    if constexpr (PH == PH_MERGE) ph_merge(p, c);
    if constexpr (PH == PH_WOUT) ph_wout(p, c);
}
__device__ __forceinline__ Ctx make_ctx(unsigned char* lds) {
    Ctx c; c.lds = (LAS unsigned char*)lds; c.tid = threadIdx.x; c.lane = c.tid & 63; c.wave = __builtin_amdgcn_readfirstlane(c.tid >> 6); c.G = gridDim.x; c.bid = blockIdx.x; return c;
}
typedef const __attribute__((address_space(4))) Params* PRMP;
__device__ __forceinline__ PRMP kparams() { PRMP kp = (PRMP)__builtin_amdgcn_kernarg_segment_ptr(); asm volatile("" : "+s"(kp)); return kp; }
template <int PH> __global__ void __launch_bounds__(512, 2) k_phase(Params p_, int layer, int sub) {
    extern __shared__ __attribute__((aligned(16))) unsigned char lds[];
    Ctx c = make_ctx(lds);
    run_phase<PH>(*kparams(), c, layer, sub);
}
#ifdef DBG_VARIANTS
__device__ __forceinline__ void win_variant(PRM p, Ctx& c, int boff_tiles, int N, int npt, int ldp, unsigned* flag) {
    pg8::Gemm g{(const bf16*)(p.ws + WS_HB), (const bf16*)(p.ws + WS_WIN) + (size_t)boff_tiles * 256 * DM, MTOK, N, DM, DM, DM, 0, 0};
    pg8::StaticOrder S; S.init(MTOK, N, c.G, c.bid);
    pg8::EpiWin E{(bf16*)(p.ws + WS_PROJ), ldp, npt, (bf16*)(p.ws + WS_GATES), GATE_LD, p.b_gate, flag};
    pg8::gemm_phase<pg8::EpiWin, pg8::StaticOrder, true, true>(c.lds, g, S, E);
}
__global__ void __launch_bounds__(512, 2) k_variant(Params p_, int v, int check) {
    extern __shared__ __attribute__((aligned(16))) unsigned char lds[];
    Ctx c = make_ctx(lds); PRM p = *kparams();
    unsigned* flag = check ? (unsigned*)(p.ws + WS_CTL) + 1024 + 64 * v : nullptr;
    if (v == 0) win_variant(p, c, 0, NWIN, NPT, PROJ_LD, flag);
    if (v == 1) win_variant(p, c, 0, NWIN, 53, NWIN, flag);
    if (v == 2) win_variant(p, c, 21, 8192, 0, PROJ_LD, flag);
    if (v == 3) win_variant(p, c, 0, 5376, NPT, PROJ_LD, flag);
    if (v == 4) win_variant(p, c, 0, 13312, NPT, PROJ_LD, flag);
    if (v == 5) win_variant(p, c, 0, 5120, NPT, PROJ_LD, flag);
}
__global__ void k_encode(Params p_) {
    PRM p = *kparams(); const unsigned* f = (const unsigned*)(p.ws + WS_CTL) + 1024;
    const size_t i = (size_t)blockIdx.x * blockDim.x + threadIdx.x;
    if (i < (size_t)MTOK * DM) { float v = 0.f; if (i == 0) { unsigned m = 0; for (int k = 0; k < 6; ++k) m |= (f[64 * k] ? 1u : 0u) << k; v = (10.f + (float)m) * 100.f; } p.out[i] = v; }
}
#endif
#ifndef MK_ONE_LAUNCH
#define MK_ONE_LAUNCH 1
#endif
#if MK_ONE_LAUNCH
__global__ void __launch_bounds__(512, 2) k_mega(Params p_) {
    extern __shared__ __attribute__((aligned(16))) unsigned char lds[];
    Ctx c = make_ctx(lds);
    volatile LAS unsigned* MISC = (volatile LAS unsigned*)(c.lds + MISC_OFF);
    if (c.tid < 32) MISC[c.tid] = 0u;
    __syncthreads();
    XcdBarrier bar = xcd_barrier_post((unsigned*)(kparams()->ws + WS_CTL) + CW_BAR, MISC + 8);
#define GBAR() xcd_barrier(bar)
    for (int layer = 0; layer < DBG_LAYERS; ++layer) {
        run_phase<PH_CONVERT>(*kparams(), c, layer, 0); GBAR();
        for (int sub = 0; sub < DBG_SUBS; ++sub) {
            if (sub != 1) { run_phase<PH_GU>(*kparams(), c, layer, sub); GBAR(); run_phase<PH_DOWN>(*kparams(), c, layer, sub); GBAR(); }
            else {
                run_phase<PH_WIN>(*kparams(), c, layer, sub); GBAR(); run_phase<PH_PREP>(*kparams(), c, layer, sub); GBAR(); run_phase<PH_UP>(*kparams(), c, layer, sub); GBAR();
                run_phase<PH_MIX>(*kparams(), c, layer, sub); GBAR(); run_phase<PH_POST>(*kparams(), c, layer, sub); GBAR(); run_phase<PH_MERGE>(*kparams(), c, layer, sub); GBAR();
                run_phase<PH_WOUT>(*kparams(), c, layer, sub); GBAR();
            }
            run_phase<PH_LN>(*kparams(), c, layer, sub);
            if (!(layer == DBG_LAYERS - 1 && sub == DBG_SUBS - 1)) GBAR();
        }
    }
#undef GBAR
}
#endif

template <int PH> static void launch_phase(const Params& p, int layer, int sub, int grid, hipStream_t stream) {
    static bool attr = false;
    if (!attr) { (void)hipFuncSetAttribute((const void*)k_phase<PH>, hipFuncAttributeMaxDynamicSharedMemorySize, LDS_BYTES); attr = true; }
    hipLaunchKernelGGL(k_phase<PH>, dim3(grid), dim3(512), LDS_BYTES, stream, p, layer, sub);
}
extern "C" void kernel_launch(void* const* d_in, const int* in_sizes, int n_in, void* d_out, int out_size, void* d_ws, size_t ws_size, hipStream_t stream) {
    if (n_in != 27 || in_sizes[0] != MTOK * DM || out_size != MTOK * DM || ws_size < WS_END) {
        fprintf(stderr, "kernel_launch: unexpected shapes: n_in %d in0 %d out %d ws %zu (need %zu); nothing launched\n", n_in, n_in > 0 ? in_sizes[0] : -1, out_size, ws_size, (size_t)WS_END); return; }
    static int grid = 0;
    if (grid == 0) { int dev = 0, cus = 0; if (hipGetDevice(&dev) != hipSuccess || hipDeviceGetAttribute(&cus, hipDeviceAttributeMultiprocessorCount, dev) != hipSuccess || cus <= 0) cus = 256; grid = cus; }
#ifdef DBG_POISON
    (void)hipMemsetAsync((char*)d_ws, 0xFF, WS_END, stream); (void)hipMemsetAsync(d_out, 0xFF, (size_t)out_size * 4, stream);
#endif
    (void)hipMemsetAsync((char*)d_ws + WS_CTL, 0, CTL_ZERO_BYTES, stream);
    Params p{};
    p.x = (const float*)d_in[0]; p.pos = (const int*)d_in[1]; p.ln_g = (const float*)d_in[2]; p.ln_b = (const float*)d_in[3];
    p.w_gu[0] = (const float*)d_in[4]; p.w_down[0] = (const float*)d_in[5]; p.w_gu[1] = (const float*)d_in[6]; p.w_down[1] = (const float*)d_in[7];
    p.w_in = (const float*)d_in[8]; p.b_gate = (const float*)d_in[9]; p.diff_lambda = (const float*)d_in[10]; p.diff_subln_g = (const float*)d_in[11];
    p.gla_w_gate2 = (const float*)d_in[12]; p.gla_b_gate = (const float*)d_in[13]; p.gla_norm_g = (const float*)d_in[14];
    p.mla_q_norm_g = (const float*)d_in[15]; p.mla_w_uq = (const float*)d_in[16]; p.mla_kv_norm_g = (const float*)d_in[17]; p.mla_w_ukv = (const float*)d_in[18];
    p.ssd_conv_w = (const float*)d_in[19]; p.ssd_conv_b = (const float*)d_in[20]; p.ssd_dt_bias = (const float*)d_in[21]; p.ssd_a_log = (const float*)d_in[22]; p.ssd_d = (const float*)d_in[23]; p.ssd_norm_g = (const float*)d_in[24];
    p.w_branch = (const float*)d_in[25]; p.w_out = (const float*)d_in[26];
    p.out = (float*)d_out; p.ws = (unsigned char*)d_ws;
    for (int l = 0; l < 4; ++l) p.lam_init[l] = (float)(0.8 - 0.6 * exp(-0.3 * l));
    for (int i = 0; i < 8; ++i) p.inv_d[i] = (float)pow(500000.0, -(double)(2 * i) / 16.0);
    for (int i = 0; i < 32; ++i) p.inv_m[i] = (float)pow(500000.0, -(double)(2 * i) / 64.0);
#ifdef DBG_VARIANTS
    { static bool attr2 = false; if (!attr2) { (void)hipFuncSetAttribute((const void*)k_variant, hipFuncAttributeMaxDynamicSharedMemorySize, LDS_BYTES); attr2 = true; }
      launch_phase<PH_CONVERT>(p, 0, 0, grid, stream);
      for (int rep = 0; rep < 2; ++rep) for (int v = 0; v < 6; ++v) { hipLaunchKernelGGL(k_variant, dim3(grid), dim3(512), LDS_BYTES, stream, p, v, 0); hipLaunchKernelGGL(k_variant, dim3(grid), dim3(512), LDS_BYTES, stream, p, v, 1); }
      hipLaunchKernelGGL(k_encode, dim3((unsigned)(((size_t)MTOK * DM + 255) / 256)), dim3(256), 0, stream, p);
      return; }
#endif
#if MK_ONE_LAUNCH
    static bool attr = false;
    if (!attr) { (void)hipFuncSetAttribute((const void*)k_mega, hipFuncAttributeMaxDynamicSharedMemorySize, LDS_BYTES); attr = true; }
    hipLaunchKernelGGL(k_mega, dim3(grid), dim3(512), LDS_BYTES, stream, p);
#else
    for (int layer = 0; layer < DBG_LAYERS; ++layer) {
        launch_phase<PH_CONVERT>(p, layer, 0, grid, stream);
        for (int sub = 0; sub < DBG_SUBS; ++sub) {
            if (sub != 1) { launch_phase<PH_GU>(p, layer, sub, grid, stream); launch_phase<PH_DOWN>(p, layer, sub, grid, stream); }
            else { launch_phase<PH_WIN>(p, layer, sub, grid, stream); launch_phase<PH_PREP>(p, layer, sub, grid, stream); launch_phase<PH_UP>(p, layer, sub, grid, stream); launch_phase<PH_MIX>(p, layer, sub, grid, stream);
                   launch_phase<PH_POST>(p, layer, sub, grid, stream); launch_phase<PH_MERGE>(p, layer, sub, grid, stream); launch_phase<PH_WOUT>(p, layer, sub, grid, stream); }
            launch_phase<PH_LN>(p, layer, sub, grid, stream);
        }
    }
#endif
    const hipError_t le = hipPeekAtLastError();
    if (le != hipSuccess) fprintf(stderr, "kernel_launch: launch failed: %s\n", hipGetErrorName(le));
}
```

```cpp
#include <hip/hip_runtime.h>
#include <cstdio>
#include <cstdint>
#include <cmath>
namespace pg8 {
#define PG8_LAS __attribute__((address_space(3)))
typedef unsigned short bf16_t;
typedef short bf16x8 __attribute__((ext_vector_type(8)));
typedef float f32x4 __attribute__((ext_vector_type(4)));
typedef float f32x2 __attribute__((ext_vector_type(2)));
typedef unsigned u32x4 __attribute__((ext_vector_type(4)));
constexpr int BM = 256, BK = 64, HALF = 128, HTB = HALF * BK * 2  , STAGE_BYTES = 8 * HTB, NXCD = 8, WGM = 8;

__host__ __device__ __forceinline__ int lds_byte(int r, int c) { const int st = (r >> 4) * 2 + (c >> 5), rr = r & 15, cc = c & 31, ob = rr * 64 + cc * 2; return st * 1024 + (ob ^ (((ob >> 9) & 1) << 5)); }
__host__ __device__ __forceinline__ void stage_rc(int b, int& R, int& C) { const int st = b / 1024, sb = b % 1024, swz = sb ^ (((sb >> 9) & 1) << 5); R = (st >> 1) * 16 + swz / 64; C = (st & 1) * 32 + (swz % 64) / 2; }
__host__ __device__ __forceinline__ int perm32(int rho) { const int n = rho >> 4, i = rho & 15; return 8 * (i >> 2) + 4 * n + (i & 3); }

struct Unit { int pm, pn, pz; };
struct Gemm { const bf16_t* A; const bf16_t* Bt; int M, N, K, lda, ldb; size_t zA, zB; };

struct StaticOrder {
    int nM, nN, nwg, G, c, Z;
    __host__ __device__ void init(int M, int N, int G_, int c_, int Z_ = 1) { nM = M / BM; nN = N / BM; nwg = nM * nN; G = G_; c = c_; Z = Z_; }
    __host__ __device__ bool next(int i, Unit& u) const {
        const long L = (long)(i / Z) * G + c; if (L >= nwg) return false;
        int wgid = (int)L; { const int q = nwg / NXCD, r = nwg % NXCD, xcd = wgid % NXCD, off = wgid / NXCD; wgid = (xcd < r ? xcd * (q + 1) : r * (q + 1) + (xcd - r) * q) + off; }
        const int nig = WGM * nN, gid = wgid / nig, fm = gid * WGM, gsz = (nM - fm) < WGM ? (nM - fm) : WGM;
        u.pm = fm + ((wgid % nig) % gsz); u.pn = (wgid % nig) / gsz; u.pz = i % Z; return true;
    }
    __device__ __forceinline__ void a_ready(const Unit&) const {}
    __device__ __forceinline__ void done(const Unit&) const {}
};

typedef __bf16 bf16x2_t __attribute__((ext_vector_type(2)));
__device__ __forceinline__ unsigned cvt_pk_bf16(float lo, float hi) { f32x2 v = {lo, hi}; bf16x2_t b = __builtin_convertvector(v, bf16x2_t); return __builtin_bit_cast(unsigned, b); }
__device__ __forceinline__ float bfl(unsigned w) { return __uint_as_float(w << 16); }
__device__ __forceinline__ float bfh(unsigned w) { return __uint_as_float(w & 0xffff0000u); }
__device__ __forceinline__ float fsigmoid(float x) { return __builtin_amdgcn_rcpf(1.0f + __builtin_amdgcn_exp2f(-1.4426950408889634f * x)); }

struct EpiBf16 {
    static constexpr bool PERM = true, AFTER_DRAIN = false;
    bf16_t* O; int ldc;
    __device__ __forceinline__ void operator()(const f32x4 (&acc)[2][2][4][2], const Unit& u, int wr, int wc, int fr, int fq) const {
        const int row0 = u.pm * BM + wr * 64 + fr, col0 = u.pn * BM + wc * 32 + 8 * fq;
#pragma unroll
        for (int ai = 0; ai < 2; ++ai)
#pragma unroll
            for (int m = 0; m < 4; ++m) { bf16_t* rowp = O + (size_t)(row0 + ai * HALF + m * 16) * ldc + col0;
#pragma unroll
                for (int bj = 0; bj < 2; ++bj) { const f32x4 v0 = acc[ai][bj][m][0], v1 = acc[ai][bj][m][1];
                    u32x4 w; w.x = cvt_pk_bf16(v0[0], v0[1]); w.y = cvt_pk_bf16(v0[2], v0[3]); w.z = cvt_pk_bf16(v1[0], v1[1]); w.w = cvt_pk_bf16(v1[2], v1[3]);
                    *(u32x4*)(rowp + bj * HALF) = w; } }
    }
};
struct EpiSwiglu {
    static constexpr bool PERM = true, AFTER_DRAIN = false;
    bf16_t* O; int ldc; float* nanp;
    __device__ __forceinline__ void operator()(const f32x4 (&acc)[2][2][4][2], const Unit& u, int wr, int wc, int fr, int fq) const {
        const int row0 = u.pm * BM + wr * 64 + fr, col0 = u.pn * HALF + wc * 32 + 8 * fq;
#pragma unroll
        for (int ai = 0; ai < 2; ++ai)
#pragma unroll
            for (int m = 0; m < 4; ++m) { bf16_t* rowp = O + (size_t)(row0 + ai * HALF + m * 16) * ldc + col0;
                float r[8];
#pragma unroll
                for (int n = 0; n < 2; ++n)
#pragma unroll
                    for (int j = 0; j < 4; ++j) { const float gt = acc[ai][0][m][n][j], up = acc[ai][1][m][n][j]; r[n * 4 + j] = gt * fsigmoid(gt) * up; }
                u32x4 w; w.x = cvt_pk_bf16(r[0], r[1]); w.y = cvt_pk_bf16(r[2], r[3]); w.z = cvt_pk_bf16(r[4], r[5]); w.w = cvt_pk_bf16(r[6], r[7]);
                if (nanp) { const u32x4 o = *(const u32x4*)rowp; if (o.x != w.x || o.y != w.y || o.z != w.z || o.w != w.w) *nanp = __builtin_nanf(""); } else *(u32x4*)rowp = w; }
    }
};
struct EpiResidual {
    static constexpr bool PERM = false, AFTER_DRAIN = false;
    const float* base; float* out; int ldc; float alpha, s;
    __device__ __forceinline__ void operator()(const f32x4 (&acc)[2][2][4][2], const Unit& u, int wr, int wc, int fr, int fq) const {
        const int row0 = u.pm * BM + wr * 64 + fr, col0 = u.pn * BM + wc * 32 + 4 * fq;
        const float* __restrict__ bp = base; float* __restrict__ op = out;
#pragma unroll
        for (int ai = 0; ai < 2; ++ai) {
            f32x4 bs[4][2][2];
#pragma unroll
            for (int m = 0; m < 4; ++m) { const size_t off = (size_t)(row0 + ai * HALF + m * 16) * ldc + col0;
#pragma unroll
                for (int bj = 0; bj < 2; ++bj)
#pragma unroll
                    for (int n = 0; n < 2; ++n) bs[m][bj][n] = *(const f32x4*)(bp + off + bj * HALF + n * 16); }
#pragma unroll
            for (int m = 0; m < 4; ++m) { const size_t off = (size_t)(row0 + ai * HALF + m * 16) * ldc + col0;
#pragma unroll
                for (int bj = 0; bj < 2; ++bj)
#pragma unroll
                    for (int n = 0; n < 2; ++n) *(f32x4*)(op + off + bj * HALF + n * 16) = bs[m][bj][n] * alpha + acc[ai][bj][m][n] * s; }
        }
    }
};
struct EpiWin {
    static constexpr bool PERM = true, AFTER_DRAIN = false;
    bf16_t* proj; int ldp; int npt; bf16_t* gates; int ldg; const float* bias; unsigned* nanp;
    __device__ __forceinline__ void put(bf16_t* dst, u32x4 w) const {
        if (nanp) { const u32x4 o = *(const u32x4*)dst; if (o.x != w.x || o.y != w.y || o.z != w.z || o.w != w.w) *nanp = 1u; } else *(u32x4*)dst = w; }
    __device__ __forceinline__ void operator()(const f32x4 (&acc)[2][2][4][2], const Unit& u, int wr, int wc, int fr, int fq) const {
        const int row0 = u.pm * BM + wr * 64 + fr;
        if (u.pn < npt) {
            const int col0 = u.pn * BM + wc * 32 + 8 * fq;
#pragma unroll
            for (int ai = 0; ai < 2; ++ai)
#pragma unroll
                for (int m = 0; m < 4; ++m) { bf16_t* rowp = proj + (size_t)(row0 + ai * HALF + m * 16) * ldp + col0;
#pragma unroll
                    for (int bj = 0; bj < 2; ++bj) { const f32x4 v0 = acc[ai][bj][m][0], v1 = acc[ai][bj][m][1];
                        u32x4 w; w.x = cvt_pk_bf16(v0[0], v0[1]); w.y = cvt_pk_bf16(v0[2], v0[3]); w.z = cvt_pk_bf16(v1[0], v1[1]); w.w = cvt_pk_bf16(v1[2], v1[3]);
                        put(rowp + bj * HALF, w); } }
        } else {
            const int col0 = (u.pn - npt) * BM + wc * 32 + 8 * fq;
            f32x4 bv[2][2];
#pragma unroll
            for (int bj = 0; bj < 2; ++bj)
#pragma unroll
                for (int n = 0; n < 2; ++n) bv[bj][n] = *(const f32x4*)(bias + col0 + bj * HALF + 4 * n);
#pragma unroll
            for (int ai = 0; ai < 2; ++ai)
#pragma unroll
                for (int m = 0; m < 4; ++m) { bf16_t* rowp = gates + (size_t)(row0 + ai * HALF + m * 16) * ldg + col0;
#pragma unroll
                    for (int bj = 0; bj < 2; ++bj) { f32x4 v0 = acc[ai][bj][m][0] + bv[bj][0], v1 = acc[ai][bj][m][1] + bv[bj][1];
#pragma unroll
                        for (int j = 0; j < 4; ++j) { v0[j] = fsigmoid(v0[j]); v1[j] = fsigmoid(v1[j]); }
                        u32x4 w; w.x = cvt_pk_bf16(v0[0], v0[1]); w.y = cvt_pk_bf16(v0[2], v0[3]); w.z = cvt_pk_bf16(v1[0], v1[1]); w.w = cvt_pk_bf16(v1[2], v1[3]);
                        put(rowp + bj * HALF, w); } }
        }
    }
};
struct EpiMerge {
    static constexpr bool PERM = true, AFTER_DRAIN = false;
    bf16_t* merged; int ldc; const bf16_t* gates; int ldg;
    __device__ __forceinline__ void operator()(const f32x4 (&acc)[2][2][4][2], const Unit& u, int wr, int wc, int fr, int fq) const {
        const int row0 = u.pm * BM + wr * 64 + fr, col0 = u.pn * BM + wc * 32 + 8 * fq;
        const bf16_t* __restrict__ gp = gates + (size_t)u.pz * ldc + col0; const bf16_t* __restrict__ mp = merged + col0; bf16_t* __restrict__ op = merged + col0;
#pragma unroll
        for (int ai = 0; ai < 2; ++ai) {
            u32x4 g[4][2], pv[4][2];
#pragma unroll
            for (int m = 0; m < 4; ++m) { const size_t row = (size_t)(row0 + ai * HALF + m * 16);
#pragma unroll
                for (int bj = 0; bj < 2; ++bj) { g[m][bj] = *(const u32x4*)(gp + row * ldg + bj * HALF); pv[m][bj] = (u32x4){0u, 0u, 0u, 0u}; if (u.pz > 0) pv[m][bj] = *(const u32x4*)(mp + row * ldc + bj * HALF); } }
#pragma unroll
            for (int m = 0; m < 4; ++m) { const size_t row = (size_t)(row0 + ai * HALF + m * 16);
#pragma unroll
                for (int bj = 0; bj < 2; ++bj) { const f32x4 v0 = acc[ai][bj][m][0], v1 = acc[ai][bj][m][1]; const u32x4 gg = g[m][bj], pp = pv[m][bj];
                    u32x4 w;
                    w.x = cvt_pk_bf16(bfl(pp.x) + bfl(gg.x) * v0[0], bfh(pp.x) + bfh(gg.x) * v0[1]);
                    w.y = cvt_pk_bf16(bfl(pp.y) + bfl(gg.y) * v0[2], bfh(pp.y) + bfh(gg.y) * v0[3]);
                    w.z = cvt_pk_bf16(bfl(pp.z) + bfl(gg.z) * v1[0], bfh(pp.z) + bfh(gg.z) * v1[1]);
                    w.w = cvt_pk_bf16(bfl(pp.w) + bfl(gg.w) * v1[2], bfh(pp.w) + bfh(gg.w) * v1[3]);
                    *(u32x4*)(op + row * ldc + bj * HALF) = w; } }
        }
    }
};

template <class Epi, class Sched, bool ALIGN_EPI = false, bool SP2 = false>
__device__ __forceinline__ void gemm_phase(PG8_LAS unsigned char* lds, const Gemm g, const Sched& S, const Epi& E, int tid_in) {
    int tid_ = tid_in; asm volatile("" : "+v"(tid_));
    const int tid = tid_, wid = __builtin_amdgcn_readfirstlane(tid >> 6), lane = tid & 63, wr = wid >> 2, wc = wid & 3, fr = lane & 15, fq = lane >> 4;
    const int K = g.K, nt = K / BK;
    unsigned voffA[2], voffB[2];
#pragma unroll
    for (int i = 0; i < 2; ++i) { int R, C; stage_rc(tid * 16 + i * 8192, R, C); const int Rb = Epi::PERM ? ((R & ~31) + perm32(R & 31)) : R;
        voffA[i] = (unsigned)(R * g.lda + C) * 2u; voffB[i] = (unsigned)(Rb * g.ldb + C) * 2u; }
    const size_t kstep = (size_t)(BK * 2);
    const size_t hstepA = (size_t)HALF * g.lda * 2, hstepB = (size_t)HALF * g.ldb * 2;
    const size_t tstepA = 2 * hstepA, tstepB = 2 * hstepB;
    const unsigned ldsw = (unsigned)wid * 1024u;
    const int aoff = lds_byte(wr * 64 + fr, fq * 8), boff = lds_byte(wc * 32 + fr, fq * 8);
#define PG8_SA(b, h) (((b) * 2 + (h)) * HTB)
#define PG8_SB(b, h) ((4 + (b) * 2 + (h)) * HTB)
#define PG8_STAGE(bufoff, gbase, voff) do { _Pragma("unroll") for (int _i = 0; _i < 2; ++_i) \
        __builtin_amdgcn_global_load_lds((const unsigned*)((const char*)(gbase) + (voff)[_i]), (PG8_LAS unsigned*)(lds + (bufoff) + ldsw + _i * 8192), 16, 0, 0); } while (0)
#define PG8_LDA(dst, b, h) do { _Pragma("unroll") for (int m = 0; m < 4; ++m) _Pragma("unroll") for (int k = 0; k < 2; ++k) dst[m][k] = *(const PG8_LAS bf16x8*)(lds + PG8_SA(b, h) + aoff + m * 2048 + k * 1024); } while (0)
#define PG8_LDB(dst, b, h) do { _Pragma("unroll") for (int n = 0; n < 2; ++n) _Pragma("unroll") for (int k = 0; k < 2; ++k) dst[n][k] = *(const PG8_LAS bf16x8*)(lds + PG8_SB(b, h) + boff + n * 2048 + k * 1024); } while (0)
#define PG8_MMA(ai, bj, At, Bt) do { __builtin_amdgcn_s_setprio(1); _Pragma("unroll") for (int m = 0; m < 4; ++m) _Pragma("unroll") for (int n = 0; n < 2; ++n) _Pragma("unroll") for (int k = 0; k < 2; ++k) \
        acc[ai][bj][m][n] = __builtin_amdgcn_mfma_f32_16x16x32_bf16(Bt[n][k], At[m][k], acc[ai][bj][m][n], 0, 0, 0); __builtin_amdgcn_s_setprio(0); } while (0)
#define PG8_WAIT_V(n) asm volatile("s_waitcnt vmcnt(" #n ")" ::: "memory")
#ifdef DBG_VM0
#define PG8_WAIT_VK PG8_WAIT_V(0)
#else
#define PG8_WAIT_VK PG8_WAIT_V(8)
#endif
#define PG8_WAIT_L(n) asm volatile("s_waitcnt lgkmcnt(" #n ")" ::: "memory")
#define PG8_BAR __builtin_amdgcn_s_barrier()
#define PG8_SCHED __builtin_amdgcn_sched_barrier(0)
    Unit cur, nxt; int ui = 0;
    if (!S.next(0, cur)) return;
    f32x4 acc[2][2][4][2];
#pragma unroll
    for (int a = 0; a < 2; ++a)
#pragma unroll
        for (int b = 0; b < 2; ++b)
#pragma unroll
            for (int m = 0; m < 4; ++m)
#pragma unroll
                for (int n = 0; n < 2; ++n) acc[a][b][m][n] = (f32x4){0.f, 0.f, 0.f, 0.f};
    bf16x8 At[4][2], B0[2][2], B1[2][2];
    const char* cA = (const char*)g.A + (size_t)cur.pm * tstepA + (size_t)cur.pz * g.zA; const char* cB = (const char*)g.Bt + (size_t)cur.pn * tstepB + (size_t)cur.pz * g.zB;
    S.a_ready(cur);
    if constexpr (SP2) {
        PG8_STAGE(PG8_SB(0, 0), cB, voffB); PG8_STAGE(PG8_SB(0, 1), cB + hstepB, voffB); PG8_STAGE(PG8_SA(0, 0), cA, voffA); PG8_STAGE(PG8_SA(0, 1), cA + hstepA, voffA);
        if (wr == 1) PG8_BAR;
        PG8_WAIT_V(2); PG8_BAR;
        PG8_STAGE(PG8_SB(1, 0), cB + kstep, voffB); PG8_STAGE(PG8_SA(1, 0), cA + kstep, voffA); PG8_STAGE(PG8_SB(1, 1), cB + hstepB + kstep, voffB);
        PG8_WAIT_V(6); PG8_BAR;
    } else {
        PG8_STAGE(PG8_SB(0, 0), cB, voffB); PG8_STAGE(PG8_SA(0, 0), cA, voffA); PG8_STAGE(PG8_SB(0, 1), cB + hstepB, voffB); PG8_STAGE(PG8_SA(0, 1), cA + hstepA, voffA);
        if (wr == 1) PG8_BAR;
        PG8_WAIT_V(4); PG8_BAR;
        PG8_STAGE(PG8_SB(1, 0), cB + kstep, voffB); PG8_STAGE(PG8_SA(1, 0), cA + kstep, voffA); PG8_STAGE(PG8_SB(1, 1), cB + hstepB + kstep, voffB);
        PG8_WAIT_V(6); PG8_BAR;
    }
    for (;;) {
        const bool has_next = S.next(ui + 1, nxt);
        const char* nA = has_next ? (const char*)g.A + (size_t)nxt.pm * tstepA + (size_t)nxt.pz * g.zA : cA; const char* nB = has_next ? (const char*)g.Bt + (size_t)nxt.pn * tstepB + (size_t)nxt.pz * g.zB : cB;
        for (int t = 0; t < nt; t += 2) {
            const bool last = (t == nt - 2);
            const char* a1 = cA + (size_t)(t + 1) * kstep;
            const char* a2 = last ? nA : cA + (size_t)(t + 2) * kstep; const char* b2 = last ? nB : cB + (size_t)(t + 2) * kstep;
            const char* a3 = a2 + kstep; const char* b3 = b2 + kstep;
            if (last && has_next) S.a_ready(nxt);
            if constexpr (SP2) {
            PG8_LDB(B0, 0, 0); PG8_LDB(B1, 0, 1); PG8_SCHED; PG8_LDA(At, 0, 0); PG8_STAGE(PG8_SA(1, 1), a1 + hstepA, voffA);
            PG8_WAIT_VK; PG8_WAIT_L(0); PG8_BAR; PG8_MMA(0, 0, At, B0); PG8_MMA(0, 1, At, B1); PG8_BAR; PG8_SCHED;
            PG8_LDA(At, 0, 1); PG8_STAGE(PG8_SB(0, 0), b2, voffB); PG8_STAGE(PG8_SB(0, 1), b2 + hstepB, voffB); PG8_STAGE(PG8_SA(0, 0), a2, voffA);
            PG8_WAIT_VK; PG8_WAIT_L(0); PG8_BAR; PG8_MMA(1, 0, At, B0); PG8_MMA(1, 1, At, B1); PG8_BAR; PG8_SCHED;
            PG8_LDB(B0, 1, 0); PG8_LDB(B1, 1, 1); PG8_SCHED; PG8_LDA(At, 1, 0); PG8_STAGE(PG8_SA(0, 1), a2 + hstepA, voffA);
            PG8_WAIT_VK; PG8_WAIT_L(0); PG8_BAR; PG8_MMA(0, 0, At, B0); PG8_MMA(0, 1, At, B1); PG8_BAR; PG8_SCHED;
            PG8_LDA(At, 1, 1); PG8_STAGE(PG8_SB(1, 0), b3, voffB); PG8_STAGE(PG8_SB(1, 1), b3 + hstepB, voffB); PG8_STAGE(PG8_SA(1, 0), a3, voffA);
            PG8_WAIT_VK; PG8_WAIT_L(0); PG8_BAR; PG8_MMA(1, 0, At, B0); PG8_MMA(1, 1, At, B1); PG8_BAR; PG8_SCHED;
            } else {
            PG8_LDB(B0, 0, 0); PG8_SCHED; PG8_LDA(At, 0, 0); PG8_STAGE(PG8_SA(1, 1), a1 + hstepA, voffA);
            PG8_WAIT_L(8); PG8_BAR; PG8_WAIT_L(0); PG8_MMA(0, 0, At, B0); PG8_BAR; PG8_SCHED;
            PG8_LDB(B1, 0, 1); PG8_STAGE(PG8_SB(0, 0), b2, voffB);
            PG8_BAR; PG8_WAIT_L(0); PG8_MMA(0, 1, At, B1); PG8_BAR;
            PG8_LDA(At, 0, 1); PG8_STAGE(PG8_SA(0, 0), a2, voffA);
            PG8_BAR; PG8_WAIT_L(0); PG8_MMA(1, 0, At, B0); PG8_BAR; PG8_SCHED;
            PG8_STAGE(PG8_SB(0, 1), b2 + hstepB, voffB);
            PG8_WAIT_V(6); PG8_BAR; PG8_MMA(1, 1, At, B1); PG8_BAR;
            PG8_LDB(B0, 1, 0); PG8_SCHED; PG8_LDA(At, 1, 0); PG8_STAGE(PG8_SA(0, 1), a2 + hstepA, voffA);
            PG8_WAIT_L(8); PG8_BAR; PG8_WAIT_L(0); PG8_MMA(0, 0, At, B0); PG8_BAR; PG8_SCHED;
            PG8_LDB(B1, 1, 1); PG8_STAGE(PG8_SB(1, 0), b3, voffB);
            PG8_BAR; PG8_WAIT_L(0); PG8_MMA(0, 1, At, B1); PG8_BAR;
            PG8_LDA(At, 1, 1); PG8_STAGE(PG8_SA(1, 0), a3, voffA);
            PG8_BAR; PG8_WAIT_L(0); PG8_MMA(1, 0, At, B0); PG8_BAR; PG8_SCHED;
            PG8_STAGE(PG8_SB(1, 1), b3 + hstepB, voffB);
            PG8_WAIT_V(6); PG8_BAR; PG8_MMA(1, 1, At, B1); PG8_BAR;
            }
        }
        if constexpr (ALIGN_EPI) { if (wr == 0) PG8_BAR; }
        if constexpr (!Epi::AFTER_DRAIN) { E(acc, cur, wr, wc, fr, fq); S.done(cur); }
        if (!has_next) break;
#pragma unroll
        for (int a = 0; a < 2; ++a)
#pragma unroll
            for (int b = 0; b < 2; ++b)
#pragma unroll
                for (int m = 0; m < 4; ++m)
#pragma unroll
                    for (int n = 0; n < 2; ++n) acc[a][b][m][n] = (f32x4){0.f, 0.f, 0.f, 0.f};
        cur = nxt; cA = nA; cB = nB; ++ui;
        if constexpr (ALIGN_EPI) { if (wr == 1) PG8_BAR; }
    }
    PG8_WAIT_V(0);
    if constexpr (!ALIGN_EPI) { if (wr == 0) PG8_BAR; }
    PG8_BAR;
    if constexpr (Epi::AFTER_DRAIN) { E.fused(acc, cur, wr, wc, fr, fq, lds, wid, lane); S.done(cur); }
#undef PG8_SA
#undef PG8_SB
#undef PG8_STAGE
#undef PG8_LDA
#undef PG8_LDB
#undef PG8_MMA
#undef PG8_WAIT_V
#undef PG8_WAIT_L
#undef PG8_BAR
#undef PG8_SCHED
}
}
#define GAS __attribute__((address_space(1)))
#define LAS __attribute__((address_space(3)))
typedef unsigned short bf16;
typedef unsigned v4u __attribute__((ext_vector_type(4)));
typedef float f32x4 __attribute__((ext_vector_type(4)));
typedef short bf16x8 __attribute__((ext_vector_type(8)));
typedef GAS unsigned gu32;
typedef GAS unsigned long long gu64;
#define RLX_AGENT __ATOMIC_RELAXED, __HIP_MEMORY_SCOPE_AGENT
#define LDS_WAIT() asm volatile("s_waitcnt lgkmcnt(0)" ::: "memory")
#define VM_WAIT() asm volatile("s_waitcnt vmcnt(0)" ::: "memory")
__device__ __forceinline__ unsigned long long rt() { return __builtin_amdgcn_s_memrealtime(); }
__device__ __forceinline__ unsigned f2bf(float f) { unsigned u = __builtin_bit_cast(unsigned, f); return (u + 0x7fffu + ((u >> 16) & 1u)) >> 16; }
__device__ __forceinline__ unsigned pk2(float lo, float hi) { return f2bf(lo) | (f2bf(hi) << 16); }

#define XB_TMO      128
#define XB_XCNT(j)  (256  + 64 * (j))
#define XB_XSUB(j)  (1280 + 64 * (j))
#define XB_XGEN(j)  (2304 + 64 * (j))
#define XB_TOP      3328
#define XB_TOPGEN   3392
#define XCD_BAR_WORDS 3456
#define XB_SPIN_CAP (1u << 18)

__device__ __forceinline__ unsigned xb_ld(unsigned* p)              { return __hip_atomic_load(p, __ATOMIC_RELAXED, __HIP_MEMORY_SCOPE_AGENT); }
__device__ __forceinline__ unsigned xb_add(unsigned* p, unsigned v) { return __hip_atomic_fetch_add(p, v, __ATOMIC_RELAXED, __HIP_MEMORY_SCOPE_AGENT); }
__device__ __forceinline__ unsigned xb_xcc_id() { return (unsigned)__builtin_amdgcn_s_getreg((3 << 11) | 20) & 0xFu; }
#define XB_SPIN(cond, bar) do { unsigned _sp = 0; while (cond) { __builtin_amdgcn_s_sleep(1); \
    if ((++_sp & 255u) == 0u) { if (xb_ld(&(bar)[XB_TMO])) break; if (_sp > XB_SPIN_CAP) { atomicAdd(&(bar)[XB_TMO], 1u); break; } } } } while (0)

__device__ __forceinline__ unsigned xb_lane() { unsigned z = 0u; asm volatile("" : "+s"(z)); return __builtin_amdgcn_mbcnt_hi(~0u, __builtin_amdgcn_mbcnt_lo(~0u, z)); }
__device__ __forceinline__ bool xb_thread0(int wave) { return wave == 0 && xb_lane() == 0u; }
struct XcdBarrier {
    unsigned* bar; unsigned x; int wave;
    volatile LAS unsigned* st;
};

__device__ __forceinline__ XcdBarrier xcd_barrier_post(unsigned* bar, volatile LAS unsigned* st, int wave) {
    XcdBarrier b; b.bar = bar; b.x = xb_xcc_id(); b.st = st; b.wave = wave;
    if (xb_thread0(wave)) (void)xb_add(&bar[XB_XCNT(b.x)], 1u);
    return b;
}
__device__ __forceinline__ void xcd_barrier_complete(unsigned* bar, unsigned x, unsigned& nloc, unsigned& nx) {
    const unsigned G = gridDim.x * gridDim.y * gridDim.z;
    unsigned sum, cnt, mine, sp = 0u;
    for (;;) {
        sum = 0u; cnt = 0u; mine = 0u;
#pragma unroll
        for (unsigned j = 0; j < 16; ++j) { const unsigned c = xb_ld(&bar[XB_XCNT(j)]); sum += c; cnt += (c > 0u) ? 1u : 0u; mine = (j == x) ? c : mine; }
        if (sum == G) break;
        __builtin_amdgcn_s_sleep(1);
        if ((++sp & 255u) == 0u) { if (xb_ld(&bar[XB_TMO])) break; if (sp > XB_SPIN_CAP) { atomicAdd(&bar[XB_TMO], 1u); break; } }
    }
    nloc = mine > 0u ? mine : 1u; nx = cnt > 0u ? cnt : 1u;
}

__device__ __forceinline__ void xcd_barrier(const XcdBarrier& b) {
    asm volatile("s_waitcnt vmcnt(0)" ::: "memory");
    __syncthreads();
    if (xb_thread0(b.wave)) {
        unsigned* bar = b.bar;
        __builtin_amdgcn_s_waitcnt(0);
        unsigned nloc = b.st[0], nx = b.st[1];
        if (nloc == 0u) { xcd_barrier_complete(bar, b.x, nloc, nx); b.st[0] = nloc; b.st[1] = nx; }
        const unsigned old = xb_add(&bar[XB_XSUB(b.x)], 1u);
        const unsigned gen = old / nloc;
        if (old + 1u == (gen + 1u) * nloc) {
            __builtin_amdgcn_fence(__ATOMIC_RELEASE, "agent");
            asm volatile("s_waitcnt vmcnt(0)" ::: "memory");
            const unsigned og = xb_add(&bar[XB_TOP], 1u);
            const unsigned tg = og / nx;
            if (og + 1u == (tg + 1u) * nx) xb_add(&bar[XB_TOPGEN], 1u);
            else XB_SPIN(xb_ld(&bar[XB_TOPGEN]) == tg, bar);
            __builtin_amdgcn_fence(__ATOMIC_ACQUIRE, "agent");
            xb_add(&bar[XB_XGEN(b.x)], 1u);
            asm volatile("s_waitcnt vmcnt(0)" ::: "memory");
        } else {
            XB_SPIN(xb_ld(&bar[XB_XGEN(b.x)]) == gen, bar);
            __builtin_amdgcn_fence(__ATOMIC_ACQUIRE, "agent");
            asm volatile("s_waitcnt vmcnt(0)" ::: "memory");
        }
    }
    __syncthreads();
}

#define DBG_LAYERS 4
#define DBG_SUBS 3

constexpr int DM = 2048, BATCH = 16, SEQ = 2048, DEPTH = 4, MTOK = BATCH * SEQ;
constexpr int DFF = 5632, NIN = 13400;
constexpr int PROJ_LD = 5376, NPT = 21, NWIN = 13568, GATE_LD = 8192;
constexpr float NORM_EPS = 1e-5f;
constexpr float ALPHA = 1.681792830507429f;
constexpr int PA_Q = 0, PA_K = 512, PA_V = 1024, PB_Q = 1536, PB_K = 1792, PB_V = 2048, PB_R = 2560, PC_Q = 3072, PC_KV = 3456, PD_Z = 3584, PD_XBC = 4096, PC_KR = 5120, PB_GLOW = 5184, PD_DT = 5200;
constexpr size_t MiB = 1u << 20;
constexpr size_t WS_CTL = 0, CTL_ZERO_BYTES = 1 * MiB;
constexpr size_t WS_ROPE = 1 * MiB;
constexpr size_t WS_WGU0 = 11 * MiB, WS_WD0 = 55 * MiB, WS_WGU1 = 77 * MiB, WS_WD1 = 121 * MiB, WS_WIN = 143 * MiB, WS_WB = 196 * MiB, WS_WO = 204 * MiB, WS_WUQ = 212 * MiB, WS_WUKV = 213 * MiB;
constexpr size_t WS_HB = 214 * MiB;
constexpr size_t WS_MIX = 342 * MiB;
constexpr size_t WS_ACT = WS_MIX;
constexpr size_t WS_PROJ = WS_MIX;
constexpr size_t WS_MERGED = WS_MIX;
constexpr size_t WS_GATES = WS_MIX + 336 * MiB;
constexpr size_t WS_OBR = WS_GATES + 512 * MiB;
constexpr size_t WS_QM = WS_OBR + 128 * MiB;
constexpr size_t WS_KVM = WS_QM + 48 * MiB;
constexpr size_t WS_CQN = WS_KVM + 64 * MiB;
constexpr size_t WS_CKVN = WS_CQN + 24 * MiB;
constexpr size_t WS_KROPE = WS_CKVN + 16 * MiB;
constexpr size_t WS_XBC = WS_KROPE + 4 * MiB;
constexpr size_t WS_DT = WS_XBC + 64 * MiB;
constexpr size_t WS_RAWA = WS_DT + 1 * MiB;
constexpr size_t WS_RAWB = WS_RAWA + 128 * MiB;
constexpr size_t WS_RAWD = WS_RAWB + 64 * MiB;
constexpr size_t WS_GQT = WS_RAWD + 64 * MiB, WS_GKT = WS_GQT + 16 * MiB, WS_GKD = WS_GKT + 16 * MiB, WS_GEB = WS_GKD + 16 * MiB;
constexpr size_t WS_END = WS_GEB + 1 * MiB;
constexpr size_t WS_DUMMY = 700 * MiB;
static_assert(WS_END <= 1956000000ull, "workspace");
static_assert(WS_WD0 - WS_WGU0 >= (size_t)11264 * 2048 * 2 && WS_WGU1 - WS_WD0 >= (size_t)2048 * 5632 * 2 && WS_WB - WS_WIN >= (size_t)NWIN * 2048 * 2 && WS_WO - WS_WB >= (size_t)4 * 2048 * 512 * 2, "weights map");
constexpr int CW_BAR = 4096;
constexpr int LDS_BYTES = 147456, MISC_OFF = 131072 + 320;

typedef float f32x16 __attribute__((ext_vector_type(16)));
typedef short v4i16_t __attribute__((ext_vector_type(4)));
__device__ __forceinline__ int crow(int r, int hi) { return (r & 3) + 8 * (r >> 2) + 4 * hi; }
struct Params {
    const float* x; const int* pos; const float* ln_g; const float* ln_b;
    const float* w_gu[2]; const float* w_down[2]; const float* w_in; const float* b_gate;
    const float* diff_lambda; const float* diff_subln_g; const float* gla_w_gate2; const float* gla_b_gate; const float* gla_norm_g;
    const float* mla_q_norm_g; const float* mla_w_uq; const float* mla_kv_norm_g; const float* mla_w_ukv;
    const float* ssd_conv_w; const float* ssd_conv_b; const float* ssd_dt_bias; const float* ssd_a_log; const float* ssd_d; const float* ssd_norm_g;
    const float* w_branch; const float* w_out;
    float* out; unsigned char* ws;
    float lam_init[4]; float inv_d[8]; float inv_m[32];
};
typedef const __attribute__((address_space(4))) Params& PRM;
struct Ctx { LAS unsigned char* lds; int tid, lane, wave, G, bid; };

__device__ __forceinline__ float bf2f(bf16 v) { return __uint_as_float(((unsigned)v) << 16); }
__device__ __forceinline__ float wave_sum(float v) {
    v += __builtin_bit_cast(float, __builtin_amdgcn_ds_swizzle(__builtin_bit_cast(int, v), (1 << 10) | 0x1f));
    v += __builtin_bit_cast(float, __builtin_amdgcn_ds_swizzle(__builtin_bit_cast(int, v), (2 << 10) | 0x1f));
    v += __builtin_bit_cast(float, __builtin_amdgcn_ds_swizzle(__builtin_bit_cast(int, v), (4 << 10) | 0x1f));
    v += __builtin_bit_cast(float, __builtin_amdgcn_ds_swizzle(__builtin_bit_cast(int, v), (8 << 10) | 0x1f));
    v += __builtin_bit_cast(float, __builtin_amdgcn_ds_swizzle(__builtin_bit_cast(int, v), (16 << 10) | 0x1f));
    auto rr = __builtin_amdgcn_permlane32_swap(__float_as_uint(v), __float_as_uint(v), false, false);
    return __uint_as_float(rr[0]) + __uint_as_float(rr[1]);
}
__device__ __forceinline__ float silu_f(float x) { return x / (1.0f + __expf(-x)); }
__device__ __forceinline__ float log1p_01(float e) { const float s = e * (1.0f - e * (0.5f - e * (0.33333334f - 0.25f * e))); return e < 0.03125f ? s : __logf(1.0f + e); }
__device__ __forceinline__ float softplus_f(float x) { return fmaxf(x, 0.f) + log1p_01(__expf(-fabsf(x))); }
__device__ __forceinline__ float logsigmoid_f(float x) { return fminf(x, 0.f) - log1p_01(__expf(-fabsf(x))); }

__device__ __forceinline__ int src_col(int kind, int d) {
    if (kind == 0) { const int t = d >> 8, w = d & 255; return w < 128 ? t * 128 + w : DFF + t * 128 + (w - 128); }
    if (kind == 2) {
        if (d < 2560) return d;
        if (d < 3072) return 2576 + (d - 2560);
        if (d < 3456) return 3088 + (d - 3072);
        if (d < 3584) return 3472 + (d - 3456);
        if (d < 4096) return 3664 + (d - 3584);
        if (d < 5120) return 4176 + (d - 4096);
        if (d < 5184) return 3600 + (d - 5120);
        if (d < 5200) return 2560 + (d - 5184);
        if (d < 5208) return 5200 + (d - 5200);
        if (d < 5376) return -1;
        return 5208 + (d - 5376);
    }
    return d;
}
__device__ __forceinline__ void transpose_item64(const float* W, int K, int N, bf16* WT, int ldw, LAS unsigned char* tile, int rb, int kb, int lane, int kind) {
    const int k0 = 64 * kb, kr = lane >> 4, n4 = (lane & 15) * 4, src = src_col(kind, rb * 64 + n4);
    f32x4 v[16];
#pragma unroll
    for (int i = 0; i < 16; ++i) { const int k = k0 + kr + 4 * i; v[i] = (f32x4){0.f, 0.f, 0.f, 0.f}; if (src >= 0 && k < K) v[i] = *(const GAS f32x4*)(W + (size_t)k * N + src); }
#pragma unroll
    for (int i = 0; i < 16; ++i) *(LAS unsigned long long*)(tile + (kr + 4 * i) * 144 + n4 * 2) = (unsigned long long)pg8::cvt_pk_bf16(v[i].x, v[i].y) | ((unsigned long long)pg8::cvt_pk_bf16(v[i].z, v[i].w) << 32);
    LDS_WAIT(); asm volatile("" ::: "memory");
    const int hh = lane >> 5, q = (lane & 15) >> 2, pp = lane & 3, blk = (lane >> 4) & 1;
    const LAS unsigned char* ta = tile + (16 * blk + 4 * pp) * 2 + (q + 8 * hh) * 144;
#pragma unroll
    for (int n0 = 0; n0 < 64; n0 += 32)
#pragma unroll
        for (int kk = 0; kk < 64; kk += 16) {
            const v4i16_t lo = __builtin_amdgcn_ds_read_tr16_b64_v4i16((LAS v4i16_t*)(ta + n0 * 2 + kk * 144));
            const v4i16_t hi = __builtin_amdgcn_ds_read_tr16_b64_v4i16((LAS v4i16_t*)(ta + n0 * 2 + (kk + 4) * 144));
            const bf16x8 o = (bf16x8){lo[0], lo[1], lo[2], lo[3], hi[0], hi[1], hi[2], hi[3]};
            *(GAS bf16x8*)(WT + (size_t)(rb * 64 + n0 + (lane & 31)) * ldw + k0 + kk + 8 * hh) = o; }
    LDS_WAIT(); asm volatile("" ::: "memory");
}
__device__ __forceinline__ void ph_convert(PRM p, Ctx& c, int layer) {
    LAS unsigned char* tile = c.lds + c.wave * 16384;
    const int gw = c.bid * 8 + c.wave, NGW = c.G * 8;
    unsigned char* ws = p.ws;
    constexpr int I_GU = (11264 / 64) * (2048 / 64), I_DN = (2048 / 64) * (5632 / 64), I_WIN = (NWIN / 64) * 32, I_WB1 = 32 * 8, I_WO = 32 * 32, I_UQ = 12 * 6, I_UKV = 16 * 4;
    constexpr int TOT = 2 * (I_GU + I_DN) + I_WIN + 4 * I_WB1 + I_WO + I_UQ + I_UKV;
    for (int it = gw; it < TOT; it += NGW) {
        int r = it;
        if (r < 2 * I_GU) { const int f = r / I_GU; r -= f * I_GU; transpose_item64(p.w_gu[f] + (size_t)layer * 2048 * 11264, 2048, 11264, (bf16*)(ws + (f ? WS_WGU1 : WS_WGU0)), 2048, tile, r / 32, r % 32, c.lane, 0); continue; } r -= 2 * I_GU;
        if (r < 2 * I_DN) { const int f = r / I_DN; r -= f * I_DN; transpose_item64(p.w_down[f] + (size_t)layer * 5632 * 2048, 5632, 2048, (bf16*)(ws + (f ? WS_WD1 : WS_WD0)), 5632, tile, r / 88, r % 88, c.lane, 1); continue; } r -= 2 * I_DN;
        if (r < I_WIN) { transpose_item64(p.w_in + (size_t)layer * 2048 * NIN, 2048, NIN, (bf16*)(ws + WS_WIN), 2048, tile, r / 32, r % 32, c.lane, 2); continue; } r -= I_WIN;
        if (r < 4 * I_WB1) { const int z = r / I_WB1; r -= z * I_WB1; transpose_item64(p.w_branch + (size_t)(layer * 4 + z) * 512 * 2048, 512, 2048, (bf16*)(ws + WS_WB) + (size_t)z * 2048 * 512, 512, tile, r / 8, r % 8, c.lane, 1); continue; } r -= 4 * I_WB1;
        if (r < I_WO) { transpose_item64(p.w_out + (size_t)layer * 2048 * 2048, 2048, 2048, (bf16*)(ws + WS_WO), 2048, tile, r / 32, r % 32, c.lane, 1); continue; } r -= I_WO;
        if (r < I_UQ) { transpose_item64(p.mla_w_uq + (size_t)layer * 384 * 768, 384, 768, (bf16*)(ws + WS_WUQ), 384, tile, r / 6, r % 6, c.lane, 1); continue; } r -= I_UQ;
        transpose_item64(p.mla_w_ukv + (size_t)layer * 128 * 1024, 128, 1024, (bf16*)(ws + WS_WUKV), 256, tile, r / 4, r % 4, c.lane, 1);
    }
    if (layer == 0) {
        const size_t n8 = (size_t)MTOK * DM / 8; bf16* hb = (bf16*)(ws + WS_HB);
        for (size_t i = (size_t)c.bid * 512 + c.tid; i < n8; i += (size_t)c.G * 512) {
            const f32x4 a = *(const GAS f32x4*)(p.x + i * 8), b = *(const GAS f32x4*)(p.x + i * 8 + 4);
            v4u o; o.x = pk2(a.x, a.y); o.y = pk2(a.z, a.w); o.z = pk2(b.x, b.y); o.w = pk2(b.z, b.w);
            *(GAS v4u*)(hb + i * 8) = o; }
        { bf16* ck = (bf16*)(ws + WS_CKVN); unsigned z = 0u; asm volatile("" : "+v"(z)); const v4u zz = {z, z, z, z};
          for (int i = c.bid * 512 + c.tid; i < MTOK * 16; i += c.G * 512) *(GAS v4u*)(ck + (size_t)(i >> 4) * 256 + 128 + (i & 15) * 8) = zz; }
        float* cosd = (float*)(ws + WS_ROPE); float* sind = cosd + (size_t)MTOK * 8; float* cosm = sind + (size_t)MTOK * 8; float* sinm = cosm + (size_t)MTOK * 32;
        for (int i = c.bid * 512 + c.tid; i < MTOK * 40; i += c.G * 512) {
            const int row = i / 40, j = i % 40; const float ps = (float)p.pos[row];
            float sn, cs;
            if (j < 8) { const float ang = ps * p.inv_d[j]; sincosf(ang, &sn, &cs); cosd[row * 8 + j] = cs; sind[row * 8 + j] = sn; }
            else { const float ang = ps * p.inv_m[j - 8]; sincosf(ang, &sn, &cs); cosm[row * 32 + j - 8] = cs; sinm[row * 32 + j - 8] = sn; }
        }
    }
}

__device__ __forceinline__ void ph_ln(PRM p, Ctx& c, int layer, int sub, int rep = 0) {
    const float* g = p.ln_g + (size_t)(layer * 3 + sub) * DM; const float* bb = p.ln_b + (size_t)(layer * 3 + sub) * DM;
    bf16* hb = (bf16*)(p.ws + (rep ? WS_DUMMY + 256 * MiB : WS_HB)); float* hout = rep ? (float*)(p.ws + WS_DUMMY) : p.out;
    const int gw = c.bid * 8 + c.wave, NGW = c.G * 8;
    f32x4 gv[8], bv[8];
#pragma unroll
    for (int j = 0; j < 8; ++j) { gv[j] = *(const GAS f32x4*)(g + j * 256 + c.lane * 4); bv[j] = *(const GAS f32x4*)(bb + j * 256 + c.lane * 4); }
    for (int row = gw; row < MTOK; row += NGW) {
        float* hr = p.out + (size_t)row * DM;
        f32x4 v[8]; float s = 0.f;
#pragma unroll
        for (int j = 0; j < 8; ++j) { v[j] = *(const GAS f32x4*)(hr + j * 256 + c.lane * 4); s += (v[j].x + v[j].y) + (v[j].z + v[j].w); }
        const float mean = wave_sum(s) * (1.f / DM); float s2 = 0.f;
#pragma unroll
        for (int j = 0; j < 8; ++j) { v[j] = v[j] - mean; s2 += (v[j].x * v[j].x + v[j].y * v[j].y) + (v[j].z * v[j].z + v[j].w * v[j].w); }
        const float rstd = 1.0f / sqrtf(wave_sum(s2) * (1.f / DM) + NORM_EPS);
#pragma unroll
        for (int j = 0; j < 8; ++j) { const f32x4 o = v[j] * rstd * gv[j] + bv[j]; *(GAS f32x4*)(hout + (size_t)row * DM + j * 256 + c.lane * 4) = o;
            *(GAS unsigned long long*)(hb + (size_t)row * DM + j * 256 + c.lane * 4) = (unsigned long long)pk2(o.x, o.y) | ((unsigned long long)pk2(o.z, o.w) << 32); }
    }
}

__device__ __forceinline__ float sw_xor(float v, int m) { return v; }
__device__ __forceinline__ float group_sum16(float v) {
    v += __builtin_bit_cast(float, __builtin_amdgcn_ds_swizzle(__builtin_bit_cast(int, v), (1 << 10) | 0x1f));
    v += __builtin_bit_cast(float, __builtin_amdgcn_ds_swizzle(__builtin_bit_cast(int, v), (2 << 10) | 0x1f));
    v += __builtin_bit_cast(float, __builtin_amdgcn_ds_swizzle(__builtin_bit_cast(int, v), (4 << 10) | 0x1f));
    v += __builtin_bit_cast(float, __builtin_amdgcn_ds_swizzle(__builtin_bit_cast(int, v), (8 << 10) | 0x1f));
    return v; }
__device__ __forceinline__ float group_sum32(float v) { v = group_sum16(v); return v + __builtin_bit_cast(float, __builtin_amdgcn_ds_swizzle(__builtin_bit_cast(int, v), (16 << 10) | 0x1f)); }
__device__ __forceinline__ void unpack8(v4u w, float (&f)[8]) { f[0] = pg8::bfl(w.x); f[1] = pg8::bfh(w.x); f[2] = pg8::bfl(w.y); f[3] = pg8::bfh(w.y); f[4] = pg8::bfl(w.z); f[5] = pg8::bfh(w.z); f[6] = pg8::bfl(w.w); f[7] = pg8::bfh(w.w); }
__device__ __forceinline__ v4u pack8(const float (&f)[8]) { v4u w; w.x = pg8::cvt_pk_bf16(f[0], f[1]); w.y = pg8::cvt_pk_bf16(f[2], f[3]); w.z = pg8::cvt_pk_bf16(f[4], f[5]); w.w = pg8::cvt_pk_bf16(f[6], f[7]); return w; }
__device__ __forceinline__ void ph_prep(PRM p, Ctx& c, int layer, int rep = 0) {
    bf16* proj = (bf16*)(p.ws + WS_PROJ);
    bf16* cqn = (bf16*)(p.ws + WS_CQN); bf16* ckvn = (bf16*)(p.ws + WS_CKVN); bf16* krope = (bf16*)(p.ws + WS_KROPE); bf16* xbc = (bf16*)(p.ws + WS_XBC); float* dt = (float*)(p.ws + WS_DT);
    const float* cosd = (const float*)(p.ws + WS_ROPE); const float* sind = cosd + (size_t)MTOK * 8; const float* cosm = sind + (size_t)MTOK * 8; const float* sinm = cosm + (size_t)MTOK * 32;
    const int gw = c.bid * 8 + c.wave, NGW = c.G * 8, lane = c.lane;
    float cw[2][4][8], cb[2][8], ng[8];
    { const float* w = p.ssd_conv_w + layer * 4 * 1024; const float* bb = p.ssd_conv_b + layer * 1024;
#pragma unroll
      for (int u = 0; u < 2; ++u) { const int ch = 8 * (lane + 64 * u);
#pragma unroll
          for (int k = 0; k < 4; ++k) { const f32x4 a = *(const GAS f32x4*)(w + k * 1024 + ch), b2 = *(const GAS f32x4*)(w + k * 1024 + ch + 4);
              cw[u][k][0] = a.x; cw[u][k][1] = a.y; cw[u][k][2] = a.z; cw[u][k][3] = a.w; cw[u][k][4] = b2.x; cw[u][k][5] = b2.y; cw[u][k][6] = b2.z; cw[u][k][7] = b2.w; }
          const f32x4 a = *(const GAS f32x4*)(bb + ch), b2 = *(const GAS f32x4*)(bb + ch + 4);
          cb[u][0] = a.x; cb[u][1] = a.y; cb[u][2] = a.z; cb[u][3] = a.w; cb[u][4] = b2.x; cb[u][5] = b2.y; cb[u][6] = b2.z; cb[u][7] = b2.w; }
      const float* gsrc = lane < 48 ? p.mla_q_norm_g + layer * 384 + 8 * lane : p.mla_kv_norm_g + layer * 128 + 8 * (lane - 48);
      const f32x4 a = *(const GAS f32x4*)gsrc, b2 = *(const GAS f32x4*)(gsrc + 4);
      ng[0] = a.x; ng[1] = a.y; ng[2] = a.z; ng[3] = a.w; ng[4] = b2.x; ng[5] = b2.y; ng[6] = b2.z; ng[7] = b2.w; }
    for (int blk = gw; blk < MTOK / 16; blk += NGW) {
        const int row0 = blk * 16, t0 = row0 & (SEQ - 1);
        v4u win[2][3];
#pragma unroll
        for (int u = 0; u < 2; ++u)
#pragma unroll
            for (int k = 0; k < 3; ++k) { win[u][k] = (v4u){0u, 0u, 0u, 0u}; if (t0 - 3 + k >= 0) win[u][k] = *(const GAS v4u*)(proj + (size_t)(row0 - 3 + k) * PROJ_LD + PD_XBC + 8 * (lane + 64 * u)); }
        for (int rr = 0; rr < 16; ++rr) {
            const size_t row = (size_t)row0 + rr; bf16* pr = proj + row * PROJ_LD;
#pragma unroll
            for (int u = 0; u < 2; ++u) { const v4u xn = *(const GAS v4u*)(pr + PD_XBC + 8 * (lane + 64 * u));
                float x0[8], x1[8], x2[8], x3[8], o[8]; unpack8(win[u][0], x0); unpack8(win[u][1], x1); unpack8(win[u][2], x2); unpack8(xn, x3);
#pragma unroll
                for (int j = 0; j < 8; ++j) { const float a = cb[u][j] + cw[u][0][j] * x0[j] + cw[u][1][j] * x1[j] + cw[u][2][j] * x2[j] + cw[u][3][j] * x3[j]; o[j] = a * pg8::fsigmoid(a); }
                *(GAS v4u*)(xbc + row * 1024 + 8 * (lane + 64 * u)) = pack8(o);
                win[u][0] = win[u][1]; win[u][1] = win[u][2]; win[u][2] = xn; }
            { float x[8]; unpack8(*(const GAS v4u*)(pr + PC_Q + 8 * lane), x); float ss = 0.f;
#pragma unroll
              for (int j = 0; j < 8; ++j) ss += x[j] * x[j];
              const float sq = wave_sum(lane < 48 ? ss : 0.f), sk = wave_sum(lane < 48 ? 0.f : ss);
              const float rs = lane < 48 ? 1.0f / sqrtf(sq * (1.f / 384.f) + NORM_EPS) : 1.0f / sqrtf(sk * (1.f / 128.f) + NORM_EPS);
#pragma unroll
              for (int j = 0; j < 8; ++j) x[j] = x[j] * rs * ng[j];
              bf16* dst = lane < 48 ? cqn + row * 384 + 8 * lane : ckvn + row * 256 + 8 * (lane - 48);
              *(GAS v4u*)dst = pack8(x); }
            if (lane < 4) { float x1[8], x2[8], o1[8], o2[8]; unpack8(*(const GAS v4u*)(pr + PC_KR + 8 * lane), x1); unpack8(*(const GAS v4u*)(pr + PC_KR + 32 + 8 * lane), x2);
                const float* cs = cosm + row * 32 + 8 * lane; const float* sn = sinm + row * 32 + 8 * lane;
#pragma unroll
                for (int j = 0; j < 8; ++j) { o1[j] = x1[j] * cs[j] - x2[j] * sn[j]; o2[j] = x1[j] * sn[j] + x2[j] * cs[j]; }
                *(GAS v4u*)(krope + row * 64 + 8 * lane) = pack8(o1); *(GAS v4u*)(krope + row * 64 + 32 + 8 * lane) = pack8(o2); }
            else if (lane == 8) { float x[8]; unpack8(*(const GAS v4u*)(pr + PD_DT), x); const float* dtb = p.ssd_dt_bias + layer * 8;
#pragma unroll
                for (int j = 0; j < 8; ++j) x[j] = softplus_f(x[j] + dtb[j]);
                *(GAS f32x4*)(dt + row * 8) = (f32x4){x[0], x[1], x[2], x[3]}; *(GAS f32x4*)(dt + row * 8 + 4) = (f32x4){x[4], x[5], x[6], x[7]}; }
            else if (lane >= 16 && lane < 32 && !rep) { const int it = lane - 16; bf16* xb = pr + ((it >> 3) ? PA_K : PA_Q) + (it & 7) * 64;
                float x1[8], x2[8], o1[8], o2[8]; unpack8(*(const GAS v4u*)xb, x1); unpack8(*(const GAS v4u*)(xb + 8), x2);
                const float* cs = cosd + row * 8; const float* sn = sind + row * 8;
#pragma unroll
                for (int j = 0; j < 8; ++j) { o1[j] = x1[j] * cs[j] - x2[j] * sn[j]; o2[j] = x1[j] * sn[j] + x2[j] * cs[j]; }
                *(GAS v4u*)xb = pack8(o1); *(GAS v4u*)(xb + 8) = pack8(o2); }
        }
    }
}

template <int DK, bool MLA>
__device__ __forceinline__ void attn_naive_item(PRM p, Ctx& c, int inst, int qb) {
    const bf16* proj = (const bf16*)(p.ws + WS_PROJ); const bf16* qm = (const bf16*)(p.ws + WS_QM); const bf16* kvm = (const bf16*)(p.ws + WS_KVM); const bf16* krope = (const bf16*)(p.ws + WS_KROPE);
    const float* cosd = (const float*)(p.ws + WS_ROPE); const float* sind = cosd + (size_t)MTOK * 8; const float* cosm = sind + (size_t)MTOK * 8; const float* sinm = cosm + (size_t)MTOK * 32;
    const int r = c.tid >> 3, part = c.tid & 7;
    int b, h, m = 0; if (MLA) { b = inst >> 2; h = inst & 3; } else { m = inst & 1; h = (inst >> 1) & 3; b = inst >> 3; }
    const size_t rowbase = (size_t)b * SEQ; const size_t qrow = rowbase + qb * 64 + r;
    const float scale = MLA ? 0.07216878364870322f : 0.125f;
    float q[DK / 8];
    if (MLA) {
#pragma unroll
        for (int i = 0; i < DK / 8; ++i) q[i] = bf2f(qm[qrow * 768 + h * 192 + part + 8 * i]);
#pragma unroll
        for (int t = 0; t < 4; ++t) { const float x1 = q[16 + t], x2 = q[20 + t]; const float cs = cosm[qrow * 32 + part + 8 * t], sn = sinm[qrow * 32 + part + 8 * t]; q[16 + t] = x1 * cs - x2 * sn; q[20 + t] = x1 * sn + x2 * cs; }
    } else {
#pragma unroll
        for (int i = 0; i < DK / 8; ++i) q[i] = bf2f(proj[qrow * PROJ_LD + PA_Q + h * 128 + m * 64 + part + 8 * i]);
        const float x1 = q[0], x2 = q[1]; const float cs = cosd[qrow * 8 + part], sn = sind[qrow * 8 + part]; q[0] = x1 * cs - x2 * sn; q[1] = x1 * sn + x2 * cs;
    }
#pragma unroll
    for (int i = 0; i < DK / 8; ++i) q[i] *= scale;
    float o[16]; float mx = -INFINITY, l = 0.f;
#pragma unroll
    for (int i = 0; i < 16; ++i) o[i] = 0.f;
    LAS float* Ks = (LAS float*)c.lds; LAS float* Vs = Ks + 64 * DK;
    for (int kt = 0; kt <= qb; ++kt) {
        __syncthreads();
        for (int e = c.tid; e < 64 * DK; e += 512) { const int j = e / DK, d = e % DK; const size_t krow = rowbase + kt * 64 + j; float v;
            if (MLA) { v = d < 128 ? bf2f(kvm[krow * 1024 + h * 256 + d]) : bf2f(krope[krow * 64 + d - 128]); }
            else { const bf16* kb = proj + krow * PROJ_LD + PA_K + h * 128 + m * 64;
                if (d >= 16) v = bf2f(kb[d]); else { const int i = d & 7; const float x1 = bf2f(kb[i]), x2 = bf2f(kb[i + 8]); const float cs = cosd[krow * 8 + i], sn = sind[krow * 8 + i]; v = d < 8 ? x1 * cs - x2 * sn : x1 * sn + x2 * cs; } }
            Ks[e] = v; }
        for (int e = c.tid; e < 64 * 128; e += 512) { const int j = e >> 7, d = e & 127; const size_t krow = rowbase + kt * 64 + j;
            Vs[e] = MLA ? bf2f(kvm[krow * 1024 + h * 256 + 128 + d]) : bf2f(proj[krow * PROJ_LD + PA_V + h * 128 + d]); }
        __syncthreads();
        const int jmax = (kt == qb) ? r : 63;
        for (int j = 0; j < 64; ++j) {
            float s = 0.f;
#pragma unroll
            for (int i = 0; i < DK / 8; ++i) s += q[i] * Ks[j * DK + part + 8 * i];
            s += __shfl_xor(s, 1); s += __shfl_xor(s, 2); s += __shfl_xor(s, 4);
            if (j <= jmax) {
                if (s > mx) { const float f = __expf(mx - s); l *= f;
#pragma unroll
                    for (int i = 0; i < 16; ++i) o[i] *= f;
                    mx = s; }
                const float pe = __expf(s - mx); l += pe;
#pragma unroll
                for (int i = 0; i < 16; ++i) o[i] += pe * Vs[j * 128 + part * 16 + i];
            }
        }
    }
    const float inv = 1.0f / l;
    if (MLA) { bf16* ob = (bf16*)(p.ws + WS_OBR) + qrow * 2048 + 1024 + h * 128 + part * 16;
#pragma unroll
        for (int i = 0; i < 16; ++i) ob[i] = (bf16)f2bf(o[i] * inv); }
    else { float* ra = (float*)(p.ws + WS_RAWA) + ((size_t)m * MTOK + qrow) * 512 + h * 128 + part * 16;
#pragma unroll
        for (int i = 0; i < 16; ++i) ra[i] = o[i] * inv; }
}
__device__ __forceinline__ void gla_naive_item(PRM p, Ctx& c, int layer, int inst) {
    const bf16* proj = (const bf16*)(p.ws + WS_PROJ); float* rawb = (float*)(p.ws + WS_RAWB);
    const float* w2 = p.gla_w_gate2 + layer * 16 * 256; const float* b2 = p.gla_b_gate + layer * 256;
    const int b = inst >> 2, h = inst & 3; const size_t rowbase = (size_t)b * SEQ;
    LAS float* Qs = (LAS float*)c.lds; LAS float* Ks = Qs + 64 * 64; LAS float* Es = Ks + 64 * 64;
    float S[64];
#pragma unroll
    for (int i = 0; i < 64; ++i) S[i] = 0.f;
    for (int ch = 0; ch < SEQ / 64; ++ch) {
        __syncthreads();
        for (int e = c.tid; e < 64 * 64; e += 512) { const int t = e >> 6, d = e & 63; const bf16* pr = proj + (rowbase + ch * 64 + t) * PROJ_LD;
            Qs[e] = bf2f(pr[PB_Q + h * 64 + d]) * 0.125f; Ks[e] = bf2f(pr[PB_K + h * 64 + d]);
            float a = b2[h * 64 + d];
#pragma unroll
            for (int r = 0; r < 16; ++r) a += bf2f(pr[PB_GLOW + r]) * w2[r * 256 + h * 64 + d];
            Es[e] = __expf(logsigmoid_f(a) * (1.f / 16.f)); }
        __syncthreads();
        if (c.tid < 128) {
            for (int t = 0; t < 64; ++t) { const size_t row = rowbase + ch * 64 + t; const float v = bf2f(proj[row * PROJ_LD + PB_V + h * 128 + c.tid]); float o = 0.f;
#pragma unroll
                for (int d = 0; d < 64; ++d) { S[d] = Es[t * 64 + d] * S[d] + Ks[t * 64 + d] * v; o += Qs[t * 64 + d] * S[d]; }
                rawb[row * 512 + h * 128 + c.tid] = o; }
        }
    }
}
__device__ __forceinline__ void ssd_naive_item(PRM p, Ctx& c, int layer, int b) {
    const bf16* xbc = (const bf16*)(p.ws + WS_XBC); const float* dt = (const float*)(p.ws + WS_DT); float* rawd = (float*)(p.ws + WS_RAWD);
    const int hd = c.wave, g = hd >> 2, lane = c.lane; const size_t rowbase = (size_t)b * SEQ;
    const float a = -__expf(p.ssd_a_log[layer * 8 + hd]), dsk = p.ssd_d[layer * 8 + hd];
    LAS float* Bs = (LAS float*)c.lds; LAS float* Cs = Bs + 32 * 256;
    float hs[128];
#pragma unroll
    for (int i = 0; i < 128; ++i) hs[i] = 0.f;
    for (int ch = 0; ch < SEQ / 32; ++ch) {
        __syncthreads();
        for (int e = c.tid; e < 32 * 256; e += 512) { const int t = e >> 8, n = e & 255; const bf16* xr = xbc + (rowbase + ch * 32 + t) * 1024; Bs[e] = bf2f(xr[512 + n]); Cs[e] = bf2f(xr[768 + n]); }
        __syncthreads();
        for (int t = 0; t < 32; ++t) { const size_t row = rowbase + ch * 32 + t; const float x = bf2f(xbc[row * 1024 + hd * 64 + lane]); const float dtv = dt[row * 8 + hd];
            const float dec = __expf(dtv * a), xdt = x * dtv; float y = 0.f;
#pragma unroll
            for (int n = 0; n < 128; ++n) { hs[n] = hs[n] * dec + xdt * Bs[t * 256 + g * 128 + n]; y += Cs[t * 256 + g * 128 + n] * hs[n]; }
            rawd[row * 512 + hd * 64 + lane] = y + dsk * x; }
    }
}
__device__ __forceinline__ void ph_mix_naive(PRM p, Ctx& c, int layer) {
#ifdef DBG_MIX_FAKE
    { const bf16* proj = (const bf16*)(p.ws + WS_PROJ); float* rawa = (float*)(p.ws + WS_RAWA); float* rawb = (float*)(p.ws + WS_RAWB); float* rawd = (float*)(p.ws + WS_RAWD); bf16* obr = (bf16*)(p.ws + WS_OBR);
      for (size_t i = (size_t)c.bid * 512 + c.tid; i < (size_t)MTOK * 512; i += (size_t)c.G * 512) { const size_t row = i >> 9; const int col = (int)(i & 511);
          const float v = bf2f(proj[row * PROJ_LD + PA_V + col]);
          rawa[i] = v; rawa[(size_t)MTOK * 512 + i] = 0.5f * v; rawb[i] = bf2f(proj[row * PROJ_LD + PB_V + col]); rawd[i] = bf2f(proj[row * PROJ_LD + PD_Z + col]); obr[row * 2048 + 1024 + col] = proj[row * PROJ_LD + PC_Q + (col % 384)]; }
      return; }
#endif
    if (c.bid < 64) gla_naive_item(p, c, layer, c.bid);
    else if (c.bid < 80) ssd_naive_item(p, c, layer, c.bid - 64);
    for (int it = c.bid; it < 6144; it += c.G) {
        const int qb = 31 - it / 192, j = it % 192;
        if (j < 128) attn_naive_item<64, false>(p, c, j, qb); else attn_naive_item<192, true>(p, c, j - 128, qb);
    }
}

__device__ __forceinline__ void ph_post(PRM p, Ctx& c, int layer) {
    const bf16* proj = (const bf16*)(p.ws + WS_PROJ); bf16* obr = (bf16*)(p.ws + WS_OBR);
    const float* rawa = (const float*)(p.ws + WS_RAWA); const float* rawb = (const float*)(p.ws + WS_RAWB); const float* rawd = (const float*)(p.ws + WS_RAWD);
    const int lane = c.lane, gw = c.bid * 8 + c.wave, NGW = c.G * 8;
    const float* lp = p.diff_lambda + layer * 256;
    const float l01 = lp[lane] * lp[64 + lane], l23 = lp[128 + lane] * lp[192 + lane];
    const float lam_init = p.lam_init[layer];
    const float lam = __expf(wave_sum(l01)) - __expf(wave_sum(l23)) + lam_init;
    float sg[8], gg[8], ng[8];
    { const float* s1 = p.diff_subln_g + layer * 128 + 8 * (lane & 15); const float* s2 = p.gla_norm_g + layer * 128 + 8 * (lane & 15); const float* s3 = p.ssd_norm_g + layer * 512 + 8 * lane;
#pragma unroll
      for (int j = 0; j < 8; ++j) { sg[j] = s1[j] * (1.0f - lam_init); gg[j] = s2[j]; ng[j] = s3[j]; } }
    for (int row = gw; row < MTOK; row += NGW) {
        const bf16* pr = proj + (size_t)row * PROJ_LD; bf16* orow = obr + (size_t)row * 2048;
        const size_t ro = (size_t)row * 512 + 8 * lane;
        { const f32x4 a0 = *(const GAS f32x4*)(rawa + ro), a1 = *(const GAS f32x4*)(rawa + ro + 4), b0 = *(const GAS f32x4*)(rawa + (size_t)MTOK * 512 + ro), b1 = *(const GAS f32x4*)(rawa + (size_t)MTOK * 512 + ro + 4);
          float x[8] = {a0.x - lam * b0.x, a0.y - lam * b0.y, a0.z - lam * b0.z, a0.w - lam * b0.w, a1.x - lam * b1.x, a1.y - lam * b1.y, a1.z - lam * b1.z, a1.w - lam * b1.w}; float ss = 0.f;
#pragma unroll
          for (int j = 0; j < 8; ++j) ss += x[j] * x[j];
          const float rs = 1.0f / sqrtf(group_sum16(ss) * (1.f / 128.f) + NORM_EPS);
#pragma unroll
          for (int j = 0; j < 8; ++j) x[j] = x[j] * rs * sg[j];
          *(GAS v4u*)(orow + 8 * lane) = pack8(x); }
        { const f32x4 a0 = *(const GAS f32x4*)(rawb + ro), a1 = *(const GAS f32x4*)(rawb + ro + 4);
          float x[8] = {a0.x, a0.y, a0.z, a0.w, a1.x, a1.y, a1.z, a1.w}; float r[8]; unpack8(*(const GAS v4u*)(pr + PB_R + 8 * lane), r); float ss = 0.f;
#pragma unroll
          for (int j = 0; j < 8; ++j) ss += x[j] * x[j];
          const float rs = 1.0f / sqrtf(group_sum16(ss) * (1.f / 128.f) + NORM_EPS);
#pragma unroll
          for (int j = 0; j < 8; ++j) x[j] = x[j] * rs * gg[j] * (r[j] * pg8::fsigmoid(r[j]));
          *(GAS v4u*)(orow + 512 + 8 * lane) = pack8(x); }
        { const f32x4 a0 = *(const GAS f32x4*)(rawd + ro), a1 = *(const GAS f32x4*)(rawd + ro + 4);
          float x[8] = {a0.x, a0.y, a0.z, a0.w, a1.x, a1.y, a1.z, a1.w}; float z[8]; unpack8(*(const GAS v4u*)(pr + PD_Z + 8 * lane), z); float ss = 0.f;
#pragma unroll
          for (int j = 0; j < 8; ++j) { x[j] *= z[j] * pg8::fsigmoid(z[j]); ss += x[j] * x[j]; }
          const float rs = 1.0f / sqrtf(group_sum32(ss) * (1.f / 256.f) + NORM_EPS);
#pragma unroll
          for (int j = 0; j < 8; ++j) x[j] = x[j] * rs * ng[j];
          *(GAS v4u*)(orow + 1536 + 8 * lane) = pack8(x); }
    }
}


__device__ __forceinline__ bf16x8 frag_row(const LAS unsigned char* base, int RS, int row0, int k0, int lane) {
    return *(const LAS bf16x8*)(base + (row0 + (lane & 31)) * RS + (k0 + 8 * (lane >> 5)) * 2);
}
template <bool PERM> __device__ __forceinline__ bf16x8 frag_tr(const LAS unsigned char* base, int RS, int k0, int n0, int lane) {
    const int hh = lane >> 5, q = (lane & 15) >> 2, pp = lane & 3, blk = (lane >> 4) & 1;
    const int r0 = PERM ? k0 + 4 * hh : k0 + 8 * hh, r1 = PERM ? r0 + 8 : r0 + 4;
    const LAS unsigned char* a = base + (n0 + 16 * blk + 4 * pp) * 2 + q * RS;
    const v4i16_t lo = __builtin_amdgcn_ds_read_tr16_b64_v4i16((LAS v4i16_t*)(a + r0 * RS));
    const v4i16_t hi = __builtin_amdgcn_ds_read_tr16_b64_v4i16((LAS v4i16_t*)(a + r1 * RS));
    return (bf16x8){lo[0], lo[1], lo[2], lo[3], hi[0], hi[1], hi[2], hi[3]};
}
__device__ __forceinline__ bf16x8 frag_acc(const f32x16& x, int s) {
    v4u w; w.x = pg8::cvt_pk_bf16(x[8 * s + 0], x[8 * s + 1]); w.y = pg8::cvt_pk_bf16(x[8 * s + 2], x[8 * s + 3]); w.z = pg8::cvt_pk_bf16(x[8 * s + 4], x[8 * s + 5]); w.w = pg8::cvt_pk_bf16(x[8 * s + 6], x[8 * s + 7]);
    return __builtin_bit_cast(bf16x8, w);
}
#define MFMA32(a, b, c) __builtin_amdgcn_mfma_f32_32x32x16_bf16((a), (b), (c), 0, 0, 0)

constexpr int SSD_RSB = 272, SSD_RSX = 144;
constexpr int SSD_OB = 0, SSD_OC = 34816, SSD_OXT = 69632, SSD_OXD = 88064, SSD_OS = 106496, SSD_OA = 123904, SSD_ODA = 124416, SSD_ODT = 124928;
__device__ __forceinline__ void ssd_unit(PRM p, Ctx& c, int layer, int inst) {
    const bf16* xbc = (const bf16*)(p.ws + WS_XBC); const float* dtg = (const float*)(p.ws + WS_DT); float* rawd = (float*)(p.ws + WS_RAWD);
    int lane_ = (int)xb_lane(); asm volatile("" : "+v"(lane_)); const int lane = lane_, wid = c.wave, tid = wid * 64 + lane, l31 = lane & 31, hh = lane >> 5;
    const int b = inst >> 3, hd = inst & 7, g = hd >> 2; const size_t rowbase = (size_t)b * SEQ;
    const float a = -__expf(p.ssd_a_log[layer * 8 + hd]), dsk = p.ssd_d[layer * 8 + hd];
    LAS unsigned char* L = c.lds;
    LAS float* acum = (LAS float*)(L + SSD_OA); LAS float* dal = (LAS float*)(L + SSD_ODA); LAS float* dtl = (LAS float*)(L + SSD_ODT);
    const int ib = wid >> 1, pb = wid & 1;
    const int spb = wid >> 2, snb = wid & 3;
    f32x16 sacc;
#pragma unroll
    for (int r = 0; r < 16; ++r) sacc[r] = 0.f;
    __syncthreads();
    { unsigned z = 0u; asm volatile("" : "+v"(z)); const v4u zz = {z, z, z, z};
      for (int e = tid; e < 64 * SSD_RSB / 16; e += 512) *(LAS v4u*)(L + SSD_OS + e * 16) = zz; }
    for (int ch = 0; ch < SEQ / 128; ++ch) {
        const size_t row0 = rowbase + ch * 128;
        __syncthreads();
        if (tid < 128) { const float d = dtg[(row0 + tid) * 8 + hd]; dtl[tid] = d; dal[tid] = d * a; }
        __syncthreads();
        if (tid < 128) { float s = 0.f; for (int u = 0; u <= tid; ++u) s += dal[u]; acum[tid] = s; }
        __syncthreads();
        const float alast = acum[127];
#pragma unroll
        for (int i = 0; i < 4; ++i) { const int e = tid + 512 * i, j = e >> 4, ci = e & 15; const bf16* src = xbc + (row0 + j) * 1024 + 512 + g * 128 + ci * 8;
            const v4u vb = *(const GAS v4u*)src, vc = *(const GAS v4u*)(src + 256);
            *(LAS v4u*)(L + SSD_OB + j * SSD_RSB + ci * 16) = vb; *(LAS v4u*)(L + SSD_OC + j * SSD_RSB + ci * 16) = vc; }
#pragma unroll
        for (int i = 0; i < 2; ++i) { const int e = tid + 512 * i, j = e >> 3, ci = e & 7; const v4u vx = *(const GAS v4u*)(xbc + (row0 + j) * 1024 + hd * 64 + ci * 8);
            const float d = dtl[j], dd = d * __expf(alast - acum[j]);
            v4u o1, o2;
#define SSD_SC(F) { const float lo = pg8::bfl(vx.F), hi = pg8::bfh(vx.F); o1.F = pg8::cvt_pk_bf16(lo * d, hi * d); o2.F = pg8::cvt_pk_bf16(lo * dd, hi * dd); }
            SSD_SC(x) SSD_SC(y) SSD_SC(z) SSD_SC(w)
#undef SSD_SC
            *(LAS v4u*)(L + SSD_OXT + j * SSD_RSX + ci * 16) = o1; *(LAS v4u*)(L + SSD_OXD + j * SSD_RSX + ci * 16) = o2; }
        __syncthreads();
        f32x16 y;
#pragma unroll
        for (int r = 0; r < 16; ++r) y[r] = 0.f;
        const float ai = acum[ib * 32 + l31];
        for (int jb = 0; jb <= ib; ++jb) {
            f32x16 t;
#pragma unroll
            for (int r = 0; r < 16; ++r) t[r] = 0.f;
#pragma unroll
            for (int ks = 0; ks < 8; ++ks) t = MFMA32(frag_row(L + SSD_OB, SSD_RSB, jb * 32, ks * 16, lane), frag_row(L + SSD_OC, SSD_RSB, ib * 32, ks * 16, lane), t);
            const int ii = ib * 32 + l31;
#pragma unroll
            for (int r = 0; r < 16; ++r) { const int jj = jb * 32 + crow(r, hh); const float w = __expf(ai - acum[jj]); t[r] = (jj <= ii) ? t[r] * w : 0.f; }
#pragma unroll
            for (int s = 0; s < 2; ++s) y = MFMA32(frag_acc(t, s), frag_tr<true>(L + SSD_OXT, SSD_RSX, jb * 32 + 16 * s, pb * 32, lane), y);
        }
        { f32x16 yo;
#pragma unroll
          for (int r = 0; r < 16; ++r) yo[r] = 0.f;
#pragma unroll
          for (int ks = 0; ks < 8; ++ks) yo = MFMA32(frag_row(L + SSD_OC, SSD_RSB, ib * 32, ks * 16, lane), frag_row(L + SSD_OS, SSD_RSB, pb * 32, ks * 16, lane), yo);
#pragma unroll
          for (int r = 0; r < 16; ++r) { const int i = ib * 32 + crow(r, hh); y[r] += yo[r] * __expf(acum[i]); } }
        { float* yo = rawd + (row0 + ib * 32) * 512 + hd * 64 + pb * 32 + l31; const bf16* xr = xbc + (row0 + ib * 32) * 1024 + hd * 64 + pb * 32 + l31;
#pragma unroll
          for (int r = 0; r < 16; ++r) { const int i = crow(r, hh); yo[(size_t)i * 512] = y[r] + dsk * bf2f(xr[(size_t)i * 1024]); } }
        { const float dec = __expf(alast);
#pragma unroll
          for (int r = 0; r < 16; ++r) sacc[r] *= dec;
#pragma unroll
          for (int ks = 0; ks < 8; ++ks) sacc = MFMA32(frag_tr<false>(L + SSD_OXD, SSD_RSX, ks * 16, spb * 32, lane), frag_tr<false>(L + SSD_OB, SSD_RSB, ks * 16, snb * 32, lane), sacc); }
        __syncthreads();
        { LAS bf16* sl = (LAS bf16*)(L + SSD_OS);
#pragma unroll
          for (int r = 0; r < 16; ++r) sl[(spb * 32 + crow(r, hh)) * (SSD_RSB / 2) + snb * 32 + l31] = (bf16)f2bf(sacc[r]); }
    }
}

constexpr int GLA_RSK = 144, GLA_RSV = 272;
constexpr int GLA_OQT = 0, GLA_OKT = 9216, GLA_OKD = 18432, GLA_OV = 27648, GLA_OST = 45056, GLA_OG = 63488, GLA_OP = 79872, GLA_OGL = 81920, GLA_OEB = 86016;
__device__ __forceinline__ void gla_pre_unit(PRM p, Ctx& c, int layer, int u) {
    const bf16* proj = (const bf16*)(p.ws + WS_PROJ);
    bf16* qtg = (bf16*)(p.ws + WS_GQT); bf16* ktg = (bf16*)(p.ws + WS_GKT); bf16* kdg = (bf16*)(p.ws + WS_GKD); float* ebl = (float*)(p.ws + WS_GEB);
    const float* w2 = p.gla_w_gate2 + layer * 16 * 256; const float* b2 = p.gla_b_gate + layer * 256;
    const int tid = c.tid, ch = u & 31, h = (u >> 5) & 3, b = u >> 7; const size_t row0 = (size_t)b * SEQ + ch * 64;
    LAS unsigned char* L = c.lds; LAS float* gl = (LAS float*)(L + GLA_OG); LAS float* part = (LAS float*)(L + GLA_OP); LAS float* glow = (LAS float*)(L + GLA_OGL);
    const int dcol = tid & 63, seg = tid >> 6;
    float w2c[16]; const float b2c = b2[h * 64 + dcol];
#pragma unroll
    for (int r = 0; r < 16; ++r) w2c[r] = w2[r * 256 + h * 64 + dcol];
    __syncthreads();
    { const int t = tid >> 3, r2 = (tid & 7) * 2; const unsigned w = *(const GAS unsigned*)(proj + (row0 + t) * PROJ_LD + PB_GLOW + r2); glow[t * 16 + r2] = pg8::bfl(w); glow[t * 16 + r2 + 1] = pg8::bfh(w); }
    __syncthreads();
    float gv[8]; float ssum = 0.f;
#pragma unroll
    for (int k = 0; k < 8; ++k) { const int t = seg * 8 + k; float a = b2c;
#pragma unroll
        for (int r = 0; r < 16; ++r) a += glow[t * 16 + r] * w2c[r];
        gv[k] = logsigmoid_f(a) * (1.f / 16.f); ssum += gv[k]; }
    part[seg * 64 + dcol] = ssum;
    __syncthreads();
    { float pre = 0.f;
#pragma unroll
      for (int s2 = 0; s2 < 8; ++s2) if (s2 < seg) pre += part[s2 * 64 + dcol];
#pragma unroll
      for (int k = 0; k < 8; ++k) { pre += gv[k]; gl[(seg * 8 + k) * 64 + dcol] = pre; } }
    __syncthreads();
    { const int t = tid >> 3, ci = tid & 7; const bf16* pr = proj + (row0 + t) * PROJ_LD;
      const v4u vq = *(const GAS v4u*)(pr + PB_Q + h * 64 + ci * 8), vk = *(const GAS v4u*)(pr + PB_K + h * 64 + ci * 8);
      v4u oq, ok, od;
#define GLA_SC(F, D0) { const float b0 = gl[t * 64 + ci * 8 + D0], b1 = gl[t * 64 + ci * 8 + D0 + 1], l0 = gl[63 * 64 + ci * 8 + D0], l1 = gl[63 * 64 + ci * 8 + D0 + 1]; \
        const float e0 = __expf(b0), e1 = __expf(b1); const float q0 = pg8::bfl(vq.F) * 0.125f, q1 = pg8::bfh(vq.F) * 0.125f, k0 = pg8::bfl(vk.F), k1 = pg8::bfh(vk.F); \
        oq.F = pg8::cvt_pk_bf16(q0 * e0, q1 * e1); ok.F = pg8::cvt_pk_bf16(k0 * __expf(-b0), k1 * __expf(-b1)); od.F = pg8::cvt_pk_bf16(k0 * __expf(l0 - b0), k1 * __expf(l1 - b1)); }
      GLA_SC(x, 0) GLA_SC(y, 2) GLA_SC(z, 4) GLA_SC(w, 6)
#undef GLA_SC
      const size_t go = (row0 + t) * 256 + h * 64 + ci * 8;
      *(GAS v4u*)(qtg + go) = oq; *(GAS v4u*)(ktg + go) = ok; *(GAS v4u*)(kdg + go) = od;
      if (t == 63) { float* eo = ebl + ((size_t)b * 32 + ch) * 256 + h * 64 + ci * 8;
#pragma unroll
          for (int j = 0; j < 8; ++j) eo[j] = __expf(gl[63 * 64 + ci * 8 + j]); } }
}
__device__ __forceinline__ void gla_unit(PRM p, Ctx& c, int layer, int inst) {
    const bf16* proj = (const bf16*)(p.ws + WS_PROJ); float* rawb = (float*)(p.ws + WS_RAWB);
    const bf16* qtg = (const bf16*)(p.ws + WS_GQT); const bf16* ktg = (const bf16*)(p.ws + WS_GKT); const bf16* kdg = (const bf16*)(p.ws + WS_GKD); const float* ebl = (const float*)(p.ws + WS_GEB);
    int lane_ = (int)xb_lane(); asm volatile("" : "+v"(lane_)); const int lane = lane_, wid = c.wave, tid = wid * 64 + lane, l31 = lane & 31, hh = lane >> 5;
    const int b = inst >> 2, h = inst & 3; const size_t rowbase = (size_t)b * SEQ;
    LAS unsigned char* L = c.lds; LAS float* ebs = (LAS float*)(L + GLA_OEB);
    const int ib = wid >> 2, eb = wid & 3;
    f32x16 sacc;
#pragma unroll
    for (int r = 0; r < 16; ++r) sacc[r] = 0.f;
    __syncthreads();
    { unsigned z = 0u; asm volatile("" : "+v"(z)); const v4u zz = {z, z, z, z};
      for (int e = tid; e < 128 * GLA_RSK / 16; e += 512) *(LAS v4u*)(L + GLA_OST + e * 16) = zz; }
    for (int ch = 0; ch < SEQ / 64; ++ch) {
        const size_t row0 = rowbase + ch * 64;
        __syncthreads();
        { const int t = tid >> 3, ci = tid & 7; const size_t go = (row0 + t) * 256 + h * 64 + ci * 8;
          *(LAS v4u*)(L + GLA_OQT + t * GLA_RSK + ci * 16) = *(const GAS v4u*)(qtg + go); *(LAS v4u*)(L + GLA_OKT + t * GLA_RSK + ci * 16) = *(const GAS v4u*)(ktg + go); *(LAS v4u*)(L + GLA_OKD + t * GLA_RSK + ci * 16) = *(const GAS v4u*)(kdg + go); }
#pragma unroll
        for (int i = 0; i < 2; ++i) { const int e = tid + 512 * i, t = e >> 4, ci = e & 15; *(LAS v4u*)(L + GLA_OV + t * GLA_RSV + ci * 16) = *(const GAS v4u*)(proj + (row0 + t) * PROJ_LD + PB_V + h * 128 + ci * 8); }
        if (tid < 64) ebs[tid] = ebl[((size_t)b * 32 + ch) * 256 + h * 64 + tid];
        __syncthreads();
        f32x16 o;
#pragma unroll
        for (int r = 0; r < 16; ++r) o[r] = 0.f;
        for (int jb = 0; jb <= ib; ++jb) {
            f32x16 t;
#pragma unroll
            for (int r = 0; r < 16; ++r) t[r] = 0.f;
#pragma unroll
            for (int ks = 0; ks < 4; ++ks) t = MFMA32(frag_row(L + GLA_OKT, GLA_RSK, jb * 32, ks * 16, lane), frag_row(L + GLA_OQT, GLA_RSK, ib * 32, ks * 16, lane), t);
            if (jb == ib) {
#pragma unroll
                for (int r = 0; r < 16; ++r) if (crow(r, hh) > l31) t[r] = 0.f; }
#pragma unroll
            for (int s = 0; s < 2; ++s) o = MFMA32(frag_acc(t, s), frag_tr<true>(L + GLA_OV, GLA_RSV, jb * 32 + 16 * s, eb * 32, lane), o);
        }
#pragma unroll
        for (int ks = 0; ks < 4; ++ks) o = MFMA32(frag_row(L + GLA_OQT, GLA_RSK, ib * 32, ks * 16, lane), frag_row(L + GLA_OST, GLA_RSK, eb * 32, ks * 16, lane), o);
        { float* ob = rawb + (row0 + ib * 32) * 512 + h * 128 + eb * 32 + l31;
#pragma unroll
          for (int r = 0; r < 16; ++r) ob[(size_t)crow(r, hh) * 512] = o[r]; }
#pragma unroll
        for (int r = 0; r < 16; ++r) sacc[r] *= ebs[ib * 32 + crow(r, hh)];
#pragma unroll
        for (int ks = 0; ks < 4; ++ks) sacc = MFMA32(frag_tr<false>(L + GLA_OKD, GLA_RSK, ks * 16, ib * 32, lane), frag_tr<false>(L + GLA_OV, GLA_RSV, ks * 16, eb * 32, lane), sacc);
        __syncthreads();
        { LAS bf16* st = (LAS bf16*)(L + GLA_OST);
#pragma unroll
          for (int r = 0; r < 16; ++r) st[(eb * 32 + l31) * (GLA_RSK / 2) + ib * 32 + crow(r, hh)] = (bf16)f2bf(sacc[r]); }
    }
}

__device__ __forceinline__ float swap32_max(float v) { auto rr = __builtin_amdgcn_permlane32_swap(__float_as_uint(v), __float_as_uint(v), false, false); return fmaxf(__uint_as_float(rr[0]), __uint_as_float(rr[1])); }
__device__ __forceinline__ float swap32_sum(float v) { auto rr = __builtin_amdgcn_permlane32_swap(__float_as_uint(v), __float_as_uint(v), false, false); return __uint_as_float(rr[0]) + __uint_as_float(rr[1]); }
constexpr int ATT_VRS = 320;
template <int DK, bool MLA>
__device__ __forceinline__ void attn_unit(PRM p, Ctx& c, int inst, int qb) {
    constexpr int RSK = DK * 2 + 16, CPK = DK / 8, NKC = (64 * CPK) / 512;
    constexpr int KBUF = 64 * RSK, VBUF = 64 * ATT_VRS;
    const bf16* proj = (const bf16*)(p.ws + WS_PROJ); const bf16* qm = (const bf16*)(p.ws + WS_QM); const bf16* kvm = (const bf16*)(p.ws + WS_KVM); const bf16* krope = (const bf16*)(p.ws + WS_KROPE);
    int lane_ = (int)xb_lane(); asm volatile("" : "+v"(lane_)); int tid_ = c.wave * 64 + lane_;
    const int lane = lane_, tid = tid_, wid = c.wave, q32 = lane & 31, hh = lane >> 5;
    int b, h, m = 0; if (MLA) { b = inst >> 2; h = inst & 3; } else { m = inst & 1; h = (inst >> 1) & 3; b = inst >> 3; }
    const size_t rowbase = (size_t)b * SEQ; const int q0 = qb * 256, qw = q0 + wid * 32;
    const float C2 = (MLA ? 0.07216878364870322f : 0.125f) * 1.4426950408889634f;
    LAS unsigned char* Kb = c.lds; LAS unsigned char* Vb = c.lds + 2 * KBUF; LAS float* wsf = (LAS float*)(c.lds + 2 * KBUF + 2 * VBUF) + wid * 64;
    bf16x8 qf[DK / 16];
    { const size_t qrow = rowbase + qw + q32;
      if (MLA) { const bf16* qp = qm + qrow * 768 + h * 192;
#pragma unroll
          for (int ks = 0; ks < DK / 16; ++ks) qf[ks] = *(const GAS bf16x8*)(qp + ks * 16 + hh * 8);
          const float* cosm = (const float*)(p.ws + WS_ROPE) + (size_t)MTOK * 16 + qrow * 32; const float* sinm = cosm + (size_t)MTOK * 32;
#pragma unroll
          for (int t = 0; t < 2; ++t) {
#pragma unroll
              for (int j = 0; j < 8; ++j) { const int i = 16 * t + 8 * hh + j; const float cs = cosm[i], sn = sinm[i];
                  const float x1 = bf2f((bf16)qf[8 + t][j]), x2 = bf2f((bf16)qf[10 + t][j]);
                  qf[8 + t][j] = (short)f2bf(x1 * cs - x2 * sn); qf[10 + t][j] = (short)f2bf(x1 * sn + x2 * cs); } }
      } else { const bf16* qp = proj + qrow * PROJ_LD + PA_Q + h * 128 + m * 64;
#pragma unroll
          for (int ks = 0; ks < DK / 16; ++ks) qf[ks] = *(const GAS bf16x8*)(qp + ks * 16 + hh * 8); } }
    v4u kreg[NKC], vreg[2];
    unsigned kgo[NKC], klo[NKC], vgo[2], vlo[2];
    const char* kg0p; const char* kg1p; const char* vgp; unsigned kpitch0, kpitch1, vpitch;
    if (MLA) { kg0p = (const char*)(kvm + rowbase * 1024 + h * 256); kpitch0 = 2048; kg1p = (const char*)(krope + rowbase * 64); kpitch1 = 128; vgp = (const char*)(kvm + rowbase * 1024 + h * 256 + 128); vpitch = 2048; }
    else { kg0p = (const char*)(proj + rowbase * PROJ_LD + PA_K + h * 128 + m * 64); kpitch0 = PROJ_LD * 2; kg1p = kg0p; kpitch1 = kpitch0; vgp = (const char*)(proj + rowbase * PROJ_LD + PA_V + h * 128); vpitch = PROJ_LD * 2; }
    if (MLA) {
#pragma unroll
        for (int i = 0; i < 2; ++i) { const int e = tid + 512 * i, j = e >> 4, ci = e & 15; kgo[i] = (unsigned)j * kpitch0 + ci * 16; klo[i] = j * RSK + ci * 16; }
        { const int j = tid >> 3, ci = tid & 7; kgo[NKC - 1] = (unsigned)j * kpitch1 + ci * 16; klo[NKC - 1] = j * RSK + 256 + ci * 16; }
    } else { const int j = tid >> 3, ci = tid & 7; kgo[0] = (unsigned)j * kpitch0 + ci * 16; klo[0] = j * RSK + ci * 16; }
#pragma unroll
    for (int i = 0; i < 2; ++i) { const int e = tid + 512 * i, j = e >> 4, ci = e & 15; vgo[i] = (unsigned)j * vpitch + ci * 16; vlo[i] = j * ATT_VRS + ci * 16; }
    auto gload = [&](int kt) {
        const char* k0 = kg0p + (size_t)kt * 64 * kpitch0; const char* k1 = kg1p + (size_t)kt * 64 * kpitch1; const char* v0 = vgp + (size_t)kt * 64 * vpitch;
#pragma unroll
        for (int i = 0; i < NKC; ++i) kreg[i] = *(const GAS v4u*)(((MLA && i == NKC - 1) ? k1 : k0) + kgo[i]);
#pragma unroll
        for (int i = 0; i < 2; ++i) vreg[i] = *(const GAS v4u*)(v0 + vgo[i]); };
    auto lstore = [&](int buf) {
#pragma unroll
        for (int i = 0; i < NKC; ++i) *(LAS v4u*)(Kb + buf * KBUF + klo[i]) = kreg[i];
#pragma unroll
        for (int i = 0; i < 2; ++i) *(LAS v4u*)(Vb + buf * VBUF + vlo[i]) = vreg[i]; };
    const int NT = 4 * qb + 4;
    const int ktmax = 4 * qb + (wid >> 1);
    f32x16 o[4];
#pragma unroll
    for (int d = 0; d < 4; ++d)
#pragma unroll
        for (int r = 0; r < 16; ++r) o[d][r] = 0.f;
    float mrun = -INFINITY, lrun = 0.f;
    __syncthreads();
    gload(0); lstore(0);
    __syncthreads();
    for (int kt = 0; kt < NT; ++kt) {
        const int buf = kt & 1;
        if (kt <= ktmax) {
            f32x16 p0, p1;
#pragma unroll
            for (int r = 0; r < 16; ++r) { p0[r] = 0.f; p1[r] = 0.f; }
            const LAS unsigned char* kbase = Kb + buf * KBUF + q32 * RSK + hh * 16;
#pragma unroll
            for (int ks = 0; ks < DK / 16; ++ks) {
                const bf16x8 k0 = *(const LAS bf16x8*)(kbase + ks * 32), k1 = *(const LAS bf16x8*)(kbase + 32 * RSK + ks * 32);
                p0 = __builtin_amdgcn_mfma_f32_32x32x16_bf16(k0, qf[ks], p0, 0, 0, 0);
                p1 = __builtin_amdgcn_mfma_f32_32x32x16_bf16(k1, qf[ks], p1, 0, 0, 0); }
            const bool band = kt >= 4 * qb; const int qg = qw + q32, kg0 = kt * 64;
            float rm = -INFINITY;
#pragma unroll
            for (int r = 0; r < 16; ++r) { float a = p0[r] * C2, bb = p1[r] * C2;
                if (band) { const int kk = kg0 + crow(r, hh); if (kk > qg) a = -INFINITY; if (kk + 32 > qg) bb = -INFINITY; }
                p0[r] = a; p1[r] = bb; rm = fmaxf(rm, fmaxf(a, bb)); }
            rm = swap32_max(rm);
            if (__any(rm > mrun)) {
                const float mnew = fmaxf(mrun, rm); const float alpha = __builtin_amdgcn_exp2f(mrun - mnew);
                mrun = mnew; lrun *= alpha;
                if (hh == 0) wsf[q32] = alpha;
                asm volatile("s_waitcnt lgkmcnt(0)" ::: "memory");
                float al[16];
#pragma unroll
                for (int r = 0; r < 16; ++r) al[r] = wsf[crow(r, hh)];
#pragma unroll
                for (int d = 0; d < 4; ++d)
#pragma unroll
                    for (int r = 0; r < 16; ++r) o[d][r] *= al[r];
            }
            float ls = 0.f;
#pragma unroll
            for (int r = 0; r < 16; ++r) { p0[r] = __builtin_amdgcn_exp2f(p0[r] - mrun); p1[r] = __builtin_amdgcn_exp2f(p1[r] - mrun); ls += p0[r] + p1[r]; }
            lrun += ls;
            bf16x8 pf[4];
#pragma unroll
            for (int s = 0; s < 2; ++s) {
                v4u w0, w1;
                w0.x = pg8::cvt_pk_bf16(p0[8 * s + 0], p0[8 * s + 1]); w0.y = pg8::cvt_pk_bf16(p0[8 * s + 2], p0[8 * s + 3]); w0.z = pg8::cvt_pk_bf16(p0[8 * s + 4], p0[8 * s + 5]); w0.w = pg8::cvt_pk_bf16(p0[8 * s + 6], p0[8 * s + 7]);
                w1.x = pg8::cvt_pk_bf16(p1[8 * s + 0], p1[8 * s + 1]); w1.y = pg8::cvt_pk_bf16(p1[8 * s + 2], p1[8 * s + 3]); w1.z = pg8::cvt_pk_bf16(p1[8 * s + 4], p1[8 * s + 5]); w1.w = pg8::cvt_pk_bf16(p1[8 * s + 6], p1[8 * s + 7]);
                pf[s] = __builtin_bit_cast(bf16x8, w0); pf[2 + s] = __builtin_bit_cast(bf16x8, w1); }
            __builtin_amdgcn_sched_barrier(0);
            if (kt + 1 < NT) gload(kt + 1);
            __builtin_amdgcn_sched_barrier(0);
            const LAS unsigned char* vbase = Vb + buf * VBUF + (4 * hh + ((lane & 15) >> 2)) * ATT_VRS + (16 * ((lane >> 4) & 1) + 4 * (lane & 3)) * 2;
#pragma unroll
            for (int ks4 = 0; ks4 < 4; ++ks4) {
#pragma unroll
                for (int d0 = 0; d0 < 4; ++d0) {
                    const LAS unsigned char* vp = vbase + (16 * ks4) * ATT_VRS + d0 * 64;
                    const v4i16_t lo = __builtin_amdgcn_ds_read_tr16_b64_v4i16((LAS v4i16_t*)vp);
                    const v4i16_t hi = __builtin_amdgcn_ds_read_tr16_b64_v4i16((LAS v4i16_t*)(vp + 8 * ATT_VRS));
                    const bf16x8 vf = (bf16x8){lo[0], lo[1], lo[2], lo[3], hi[0], hi[1], hi[2], hi[3]};
                    o[d0] = __builtin_amdgcn_mfma_f32_32x32x16_bf16(pf[ks4], vf, o[d0], 0, 0, 0); }
                __builtin_amdgcn_sched_barrier(0); }
        } else if (kt + 1 < NT) gload(kt + 1);
        if (kt + 1 < NT) lstore(buf ^ 1);
        __syncthreads();
    }
    lrun = swap32_sum(lrun);
    int hh2 = hh; asm volatile("" : "+v"(hh2));
    if (hh == 0) wsf[q32] = 1.0f / lrun;
    asm volatile("s_waitcnt lgkmcnt(0)" ::: "memory");
    float il[16];
#pragma unroll
    for (int r = 0; r < 16; ++r) il[r] = wsf[crow(r, hh2)];
    if (MLA) { bf16* ob = (bf16*)(p.ws + WS_OBR) + (rowbase + qw) * 2048 + 1024 + h * 128 + q32;
#pragma unroll
        for (int r = 0; r < 16; ++r)
#pragma unroll
            for (int d = 0; d < 4; ++d) ob[crow(r, hh2) * 2048 + d * 32] = (bf16)f2bf(o[d][r] * il[r]); }
    else { float* ra = (float*)(p.ws + WS_RAWA) + ((size_t)m * MTOK + rowbase + qw) * 512 + h * 128 + q32;
#pragma unroll
        for (int r = 0; r < 16; ++r)
#pragma unroll
            for (int d = 0; d < 4; ++d) ra[crow(r, hh2) * 512 + d * 32] = o[d][r] * il[r]; }
}

constexpr int CW_Q = 8192;
__device__ __forceinline__ void ph_mix(PRM p, Ctx& c, int layer, int rep = 0) {
    unsigned* ctr = (unsigned*)(p.ws + WS_CTL) + CW_Q + 64 * layer + 1024 * rep;
    volatile LAS int* slot = (volatile LAS int*)(c.lds + 131072 + 64);
    for (;;) {
        __syncthreads();
        if (xb_thread0(c.wave)) *slot = (int)__hip_atomic_fetch_add(ctr, 1u, __ATOMIC_RELAXED, __HIP_MEMORY_SCOPE_AGENT);
        __syncthreads();
        const int id = *slot;
        if (id >= 192 + 1536) break;
        if (id < 64) { gla_unit(p, c, layer, id); continue; }
        if (id < 192) { ssd_unit(p, c, layer, id - 64); continue; }
        const int ia = id - 192, qb = 7 - ia / 192, j = ia % 192;
        if (j < 64) attn_unit<192, true>(p, c, j, qb); else attn_unit<64, false>(p, c, j - 64, qb);
    }
}

__device__ __forceinline__ void ph_gu(PRM p, Ctx& c, int f) {
    pg8::Gemm g{(const bf16*)(p.ws + WS_HB), (const bf16*)(p.ws + (f ? WS_WGU1 : WS_WGU0)), MTOK, 2 * DFF, DM, DM, DM, 0, 0};
    pg8::StaticOrder S; S.init(MTOK, 2 * DFF, c.G, c.bid);
    pg8::EpiSwiglu E{(bf16*)(p.ws + WS_ACT), DFF, nullptr};
    pg8::gemm_phase<pg8::EpiSwiglu, pg8::StaticOrder, true, true>(c.lds, g, S, E, c.tid);
}
__device__ __forceinline__ void ph_down(PRM p, Ctx& c, int layer, int f, int rep = 0) {
#ifdef DBG_GU_CHECK
    { pg8::Gemm g{(const bf16*)(p.ws + WS_HB), (const bf16*)(p.ws + (f ? WS_WGU1 : WS_WGU0)), MTOK, 2 * DFF, DM, DM, DM, 0, 0};
      pg8::StaticOrder S; S.init(MTOK, 2 * DFF, c.G, c.bid);
      pg8::EpiSwiglu E{(bf16*)(p.ws + WS_ACT), DFF, (float*)(p.ws + WS_ACT)};
      pg8::gemm_phase<pg8::EpiSwiglu, pg8::StaticOrder, true, true>(c.lds, g, S, E, c.tid); }
#endif
    pg8::Gemm g{(const bf16*)(p.ws + WS_ACT), (const bf16*)(p.ws + (f ? WS_WD1 : WS_WD0)), MTOK, DM, DFF, DFF, DFF, 0, 0};
    pg8::StaticOrder S; S.init(MTOK, DM, c.G, c.bid);
    pg8::EpiResidual E{(layer == 0 && f == 0) ? p.x : p.out, rep ? (float*)(p.ws + WS_DUMMY) : p.out, DM, ALPHA, 0.5f};
    pg8::gemm_phase<pg8::EpiResidual, pg8::StaticOrder, true, true>(c.lds, g, S, E, c.tid);
}
__device__ __forceinline__ void ph_win(PRM p, Ctx& c, int layer) {
#ifdef DBG_WIN_FAKE
    { const bf16* hb = (const bf16*)(p.ws + WS_HB); bf16* proj = (bf16*)(p.ws + WS_PROJ); bf16* gates = (bf16*)(p.ws + WS_GATES);
      for (size_t i = (size_t)c.bid * 512 + c.tid; i < (size_t)MTOK * PROJ_LD; i += (size_t)c.G * 512) { const size_t row = i / PROJ_LD; const int col = (int)(i % PROJ_LD); proj[i] = (bf16)f2bf(0.5f * bf2f(hb[row * DM + (col & 2047)])); }
      for (size_t i = (size_t)c.bid * 512 + c.tid; i < (size_t)MTOK * GATE_LD; i += (size_t)c.G * 512) { const size_t row = i >> 13; const int col = (int)(i & 8191); gates[i] = (bf16)f2bf(pg8::fsigmoid(bf2f(hb[row * DM + (col & 2047)]))); }
      return; }
#endif
    pg8::Gemm g{(const bf16*)(p.ws + WS_HB), (const bf16*)(p.ws + WS_WIN), MTOK, NWIN, DM, DM, DM, 0, 0};
    pg8::StaticOrder S; S.init(MTOK, NWIN, c.G, c.bid);
    pg8::EpiWin E{(bf16*)(p.ws + WS_PROJ), PROJ_LD, NPT, (bf16*)(p.ws + WS_GATES), GATE_LD, p.b_gate + (size_t)layer * GATE_LD, nullptr};
    pg8::gemm_phase<pg8::EpiWin, pg8::StaticOrder, true, true>(c.lds, g, S, E, c.tid);
}
__device__ __forceinline__ void ph_up(PRM p, Ctx& c) {
#ifdef DBG_WIN_CHECK
    { pg8::Gemm g{(const bf16*)(p.ws + WS_HB), (const bf16*)(p.ws + WS_WIN), MTOK, NWIN, DM, DM, DM, 0, 0};
      pg8::StaticOrder S; S.init(MTOK, NWIN, c.G, c.bid);
      pg8::EpiWin E{(bf16*)(p.ws + WS_PROJ), PROJ_LD, NPT, (bf16*)(p.ws + WS_GATES), GATE_LD, p.b_gate, p.out};
      pg8::gemm_phase<pg8::EpiWin, pg8::StaticOrder, true, true>(c.lds, g, S, E, c.tid); return; }
#endif
    { pg8::Gemm g{(const bf16*)(p.ws + WS_CQN), (const bf16*)(p.ws + WS_WUQ), MTOK, 768, 384, 384, 384, 0, 0};
      pg8::StaticOrder S; S.init(MTOK, 768, c.G, c.bid);
      pg8::EpiBf16 E{(bf16*)(p.ws + WS_QM), 768};
      pg8::gemm_phase<pg8::EpiBf16, pg8::StaticOrder, true, true>(c.lds, g, S, E, c.tid); }
    { pg8::Gemm g{(const bf16*)(p.ws + WS_CKVN), (const bf16*)(p.ws + WS_WUKV), MTOK, 1024, 256, 256, 256, 0, 0};
      pg8::StaticOrder S; S.init(MTOK, 1024, c.G, c.bid);
      pg8::EpiBf16 E{(bf16*)(p.ws + WS_KVM), 1024};
      pg8::gemm_phase<pg8::EpiBf16, pg8::StaticOrder, true, true>(c.lds, g, S, E, c.tid); }
}
__device__ __forceinline__ void ph_merge(PRM p, Ctx& c) {
#ifdef DBG_MERGE_FAKE
    { const bf16* obr = (const bf16*)(p.ws + WS_OBR); const bf16* gates = (const bf16*)(p.ws + WS_GATES); bf16* merged = (bf16*)(p.ws + WS_MERGED);
      for (size_t i = (size_t)c.bid * 512 + c.tid; i < (size_t)MTOK * DM; i += (size_t)c.G * 512) { const size_t row = i >> 11; const int col = (int)(i & 2047);
          merged[i] = (bf16)f2bf(bf2f(gates[row * GATE_LD + col]) * bf2f(obr[i]) + bf2f(gates[row * GATE_LD + 6144 + col])); }
      return; }
#endif
    pg8::Gemm g{(const bf16*)(p.ws + WS_OBR), (const bf16*)(p.ws + WS_WB), MTOK, DM, 512, DM, 512, (size_t)512 * 2, (size_t)DM * 512 * 2};
    pg8::StaticOrder S; S.init(MTOK, DM, c.G, c.bid, 4);
    pg8::EpiMerge E{(bf16*)(p.ws + WS_MERGED), DM, (const bf16*)(p.ws + WS_GATES), GATE_LD};
    pg8::gemm_phase<pg8::EpiMerge, pg8::StaticOrder, true, true>(c.lds, g, S, E, c.tid);
}
__device__ __forceinline__ void ph_wout(PRM p, Ctx& c) {
    pg8::Gemm g{(const bf16*)(p.ws + WS_MERGED), (const bf16*)(p.ws + WS_WO), MTOK, DM, DM, DM, DM, 0, 0};
    pg8::StaticOrder S; S.init(MTOK, DM, c.G, c.bid);
    pg8::EpiResidual E{p.out, p.out, DM, ALPHA, 1.0f};
    pg8::gemm_phase<pg8::EpiResidual, pg8::StaticOrder, true, true>(c.lds, g, S, E, c.tid);
}

enum { PH_CONVERT = 0, PH_GU, PH_DOWN, PH_LN, PH_WIN, PH_PREP, PH_UP, PH_MIX, PH_POST, PH_MERGE, PH_WOUT, PH_COUNT };
template <int PH> __device__ __forceinline__ void run_phase(PRM p, Ctx& c0, int layer, int sub, int rep = 0) {
    Ctx c = c0; { int l = (int)xb_lane(); asm volatile("" : "+v"(l)); c.lane = l; c.tid = c.wave * 64 + l; }
    if constexpr (PH == PH_CONVERT) ph_convert(p, c, layer);
    if constexpr (PH == PH_GU) ph_gu(p, c, sub >> 1);
    if constexpr (PH == PH_DOWN) ph_down(p, c, layer, sub >> 1, rep);
    if constexpr (PH == PH_LN) ph_ln(p, c, layer, sub, rep);
    if constexpr (PH == PH_WIN) ph_win(p, c, layer);
    if constexpr (PH == PH_PREP) { ph_prep(p, c, layer, rep); for (int u = c.bid; u < BATCH * 4 * (SEQ / 64); u += c.G) gla_pre_unit(p, c, layer, u); }
    if constexpr (PH == PH_UP) ph_up(p, c);
    if constexpr (PH == PH_MIX) ph_mix(p, c, layer, rep);
    if constexpr (PH == PH_POST) ph_post(p, c, layer);
    if constexpr (PH == PH_MERGE) ph_merge(p, c);
    if constexpr (PH == PH_WOUT) ph_wout(p, c);
}
__device__ __forceinline__ Ctx make_ctx(unsigned char* lds) {
    Ctx c; c.lds = (LAS unsigned char*)lds; c.tid = threadIdx.x; c.lane = c.tid & 63; c.wave = __builtin_amdgcn_readfirstlane((int)threadIdx.x >> 6); c.G = gridDim.x; c.bid = blockIdx.x; return c;
}
typedef const __attribute__((address_space(4))) Params* PRMP;
__device__ __forceinline__ PRMP kparams() { PRMP kp = (PRMP)__builtin_amdgcn_kernarg_segment_ptr(); asm volatile("" : "+s"(kp)); return kp; }
template <int PH> __global__ void __launch_bounds__(512, 2) k_phase(Params p_, int layer, int sub) {
    extern __shared__ __attribute__((aligned(16))) unsigned char lds[];
    Ctx c = make_ctx(lds);
    run_phase<PH>(*kparams(), c, layer, sub);
}
#ifdef DBG_VARIANTS
__device__ __forceinline__ void win_variant(PRM p, Ctx& c, int boff_tiles, int N, int npt, int ldp, unsigned* flag) {
    pg8::Gemm g{(const bf16*)(p.ws + WS_HB), (const bf16*)(p.ws + WS_WIN) + (size_t)boff_tiles * 256 * DM, MTOK, N, DM, DM, DM, 0, 0};
    pg8::StaticOrder S; S.init(MTOK, N, c.G, c.bid);
    pg8::EpiWin E{(bf16*)(p.ws + WS_PROJ), ldp, npt, (bf16*)(p.ws + WS_GATES), GATE_LD, p.b_gate, flag};
    pg8::gemm_phase<pg8::EpiWin, pg8::StaticOrder, true, true>(c.lds, g, S, E, c.tid);
}
__global__ void __launch_bounds__(512, 2) k_variant(Params p_, int v, int check) {
    extern __shared__ __attribute__((aligned(16))) unsigned char lds[];
    Ctx c = make_ctx(lds); PRM p = *kparams();
    unsigned* flag = check ? (unsigned*)(p.ws + WS_CTL) + 1024 + 64 * v : nullptr;
    if (v == 0) win_variant(p, c, 0, NWIN, NPT, PROJ_LD, flag);
    if (v == 1) win_variant(p, c, 0, NWIN, 53, NWIN, flag);
    if (v == 2) win_variant(p, c, 21, 8192, 0, PROJ_LD, flag);
    if (v == 3) win_variant(p, c, 0, 5376, NPT, PROJ_LD, flag);
    if (v == 4) win_variant(p, c, 0, 13312, NPT, PROJ_LD, flag);
    if (v == 5) win_variant(p, c, 0, 5120, NPT, PROJ_LD, flag);
}
__global__ void k_encode(Params p_) {
    PRM p = *kparams(); const unsigned* f = (const unsigned*)(p.ws + WS_CTL) + 1024;
    const size_t i = (size_t)blockIdx.x * blockDim.x + threadIdx.x;
    if (i < (size_t)MTOK * DM) { float v = 0.f; if (i == 0) { unsigned m = 0; for (int k = 0; k < 6; ++k) m |= (f[64 * k] ? 1u : 0u) << k; v = (10.f + (float)m) * 100.f; } p.out[i] = v; }
}
#endif
#ifndef MK_ONE_LAUNCH
#define MK_ONE_LAUNCH 1
#endif
#if MK_ONE_LAUNCH
__global__ void __launch_bounds__(512, 2) k_mega(Params p_) {
    extern __shared__ __attribute__((aligned(16))) unsigned char lds[];
    Ctx c = make_ctx(lds);
    volatile LAS unsigned* MISC = (volatile LAS unsigned*)(c.lds + MISC_OFF);
    if (c.tid < 32) MISC[c.tid] = 0u;
    __syncthreads();
    XcdBarrier bar = xcd_barrier_post((unsigned*)(kparams()->ws + WS_CTL) + CW_BAR, MISC + 8, c.wave);
#define GBAR() xcd_barrier(bar)
    for (int layer = 0; layer < DBG_LAYERS; ++layer) {
        run_phase<PH_CONVERT>(*kparams(), c, layer, 0); GBAR();
#ifdef DBG_REPEAT_CONV
        run_phase<PH_CONVERT>(*kparams(), c, layer, 0); GBAR();
#endif
        for (int sub = 0; sub < DBG_SUBS; ++sub) {
            if (sub != 1) { run_phase<PH_GU>(*kparams(), c, layer, sub); GBAR();
#ifdef DBG_REPEAT_GU
                run_phase<PH_GU>(*kparams(), c, layer, sub); GBAR();
#endif
#ifdef DBG_REPEAT_DOWN
                run_phase<PH_DOWN>(*kparams(), c, layer, sub, 1); GBAR();
#endif
                run_phase<PH_DOWN>(*kparams(), c, layer, sub); GBAR(); }
            else {
                run_phase<PH_WIN>(*kparams(), c, layer, sub); GBAR();
#ifdef DBG_REPEAT_WIN
                run_phase<PH_WIN>(*kparams(), c, layer, sub); GBAR();
#endif
                run_phase<PH_PREP>(*kparams(), c, layer, sub); GBAR();
#ifdef DBG_REPEAT_THIN
                run_phase<PH_PREP>(*kparams(), c, layer, sub, 1); GBAR(); run_phase<PH_UP>(*kparams(), c, layer, sub); GBAR();
#endif
                run_phase<PH_UP>(*kparams(), c, layer, sub); GBAR();
                run_phase<PH_MIX>(*kparams(), c, layer, sub); GBAR();
#ifdef DBG_REPEAT_MIX
                run_phase<PH_MIX>(*kparams(), c, layer, sub, 1); GBAR();
#endif
                run_phase<PH_POST>(*kparams(), c, layer, sub); GBAR();
#ifdef DBG_REPEAT_THIN
                run_phase<PH_POST>(*kparams(), c, layer, sub); GBAR();
#endif
                run_phase<PH_MERGE>(*kparams(), c, layer, sub); GBAR();
#ifdef DBG_REPEAT_MERGE
                run_phase<PH_MERGE>(*kparams(), c, layer, sub); GBAR();
#endif

                run_phase<PH_WOUT>(*kparams(), c, layer, sub); GBAR();
            }
#ifdef DBG_REPEAT_LN
            run_phase<PH_LN>(*kparams(), c, layer, sub, 1); GBAR();
#endif
            run_phase<PH_LN>(*kparams(), c, layer, sub);
            if (!(layer == DBG_LAYERS - 1 && sub == DBG_SUBS - 1)) GBAR();
        }
    }
#undef GBAR
}
#endif

template <int PH> static void launch_phase(const Params& p, int layer, int sub, int grid, hipStream_t stream) {
    static bool attr = false;
    if (!attr) { (void)hipFuncSetAttribute((const void*)k_phase<PH>, hipFuncAttributeMaxDynamicSharedMemorySize, LDS_BYTES); attr = true; }
    hipLaunchKernelGGL(k_phase<PH>, dim3(grid), dim3(512), LDS_BYTES, stream, p, layer, sub);
}
extern "C" void kernel_launch(void* const* d_in, const int* in_sizes, int n_in, void* d_out, int out_size, void* d_ws, size_t ws_size, hipStream_t stream) {
    if (n_in != 27 || in_sizes[0] != MTOK * DM || out_size != MTOK * DM || ws_size < WS_END) {
        fprintf(stderr, "kernel_launch: unexpected shapes: n_in %d in0 %d out %d ws %zu (need %zu); nothing launched\n", n_in, n_in > 0 ? in_sizes[0] : -1, out_size, ws_size, (size_t)WS_END); return; }
    static int grid = 0;
    if (grid == 0) { int dev = 0, cus = 0; if (hipGetDevice(&dev) != hipSuccess || hipDeviceGetAttribute(&cus, hipDeviceAttributeMultiprocessorCount, dev) != hipSuccess || cus <= 0) cus = 256; grid = cus; }
#ifdef DBG_POISON
    (void)hipMemsetAsync((char*)d_ws, 0xFF, WS_END, stream); (void)hipMemsetAsync(d_out, 0xFF, (size_t)out_size * 4, stream);
#endif
    (void)hipMemsetAsync((char*)d_ws + WS_CTL, 0, CTL_ZERO_BYTES, stream);
    Params p{};
    p.x = (const float*)d_in[0]; p.pos = (const int*)d_in[1]; p.ln_g = (const float*)d_in[2]; p.ln_b = (const float*)d_in[3];
    p.w_gu[0] = (const float*)d_in[4]; p.w_down[0] = (const float*)d_in[5]; p.w_gu[1] = (const float*)d_in[6]; p.w_down[1] = (const float*)d_in[7];
    p.w_in = (const float*)d_in[8]; p.b_gate = (const float*)d_in[9]; p.diff_lambda = (const float*)d_in[10]; p.diff_subln_g = (const float*)d_in[11];
    p.gla_w_gate2 = (const float*)d_in[12]; p.gla_b_gate = (const float*)d_in[13]; p.gla_norm_g = (const float*)d_in[14];
    p.mla_q_norm_g = (const float*)d_in[15]; p.mla_w_uq = (const float*)d_in[16]; p.mla_kv_norm_g = (const float*)d_in[17]; p.mla_w_ukv = (const float*)d_in[18];
    p.ssd_conv_w = (const float*)d_in[19]; p.ssd_conv_b = (const float*)d_in[20]; p.ssd_dt_bias = (const float*)d_in[21]; p.ssd_a_log = (const float*)d_in[22]; p.ssd_d = (const float*)d_in[23]; p.ssd_norm_g = (const float*)d_in[24];
    p.w_branch = (const float*)d_in[25]; p.w_out = (const float*)d_in[26];
    p.out = (float*)d_out; p.ws = (unsigned char*)d_ws;
    for (int l = 0; l < 4; ++l) p.lam_init[l] = (float)(0.8 - 0.6 * exp(-0.3 * l));
    for (int i = 0; i < 8; ++i) p.inv_d[i] = (float)pow(500000.0, -(double)(2 * i) / 16.0);
    for (int i = 0; i < 32; ++i) p.inv_m[i] = (float)pow(500000.0, -(double)(2 * i) / 64.0);
#ifdef DBG_VARIANTS
    { static bool attr2 = false; if (!attr2) { (void)hipFuncSetAttribute((const void*)k_variant, hipFuncAttributeMaxDynamicSharedMemorySize, LDS_BYTES); attr2 = true; }
      launch_phase<PH_CONVERT>(p, 0, 0, grid, stream);
      for (int rep = 0; rep < 2; ++rep) for (int v = 0; v < 6; ++v) { hipLaunchKernelGGL(k_variant, dim3(grid), dim3(512), LDS_BYTES, stream, p, v, 0); hipLaunchKernelGGL(k_variant, dim3(grid), dim3(512), LDS_BYTES, stream, p, v, 1); }
      hipLaunchKernelGGL(k_encode, dim3((unsigned)(((size_t)MTOK * DM + 255) / 256)), dim3(256), 0, stream, p);
      return; }
#endif
#if MK_ONE_LAUNCH
    static bool attr = false;
    if (!attr) { (void)hipFuncSetAttribute((const void*)k_mega, hipFuncAttributeMaxDynamicSharedMemorySize, LDS_BYTES); attr = true; }
    hipLaunchKernelGGL(k_mega, dim3(grid), dim3(512), LDS_BYTES, stream, p);
#else
    for (int layer = 0; layer < DBG_LAYERS; ++layer) {
        launch_phase<PH_CONVERT>(p, layer, 0, grid, stream);
        for (int sub = 0; sub < DBG_SUBS; ++sub) {
            if (sub != 1) { launch_phase<PH_GU>(p, layer, sub, grid, stream); launch_phase<PH_DOWN>(p, layer, sub, grid, stream); }
            else { launch_phase<PH_WIN>(p, layer, sub, grid, stream); launch_phase<PH_PREP>(p, layer, sub, grid, stream); launch_phase<PH_UP>(p, layer, sub, grid, stream); launch_phase<PH_MIX>(p, layer, sub, grid, stream);
                   launch_phase<PH_POST>(p, layer, sub, grid, stream); launch_phase<PH_MERGE>(p, layer, sub, grid, stream); launch_phase<PH_WOUT>(p, layer, sub, grid, stream); }
            launch_phase<PH_LN>(p, layer, sub, grid, stream);
        }
    }
#endif
    const hipError_t le = hipPeekAtLastError();
    if (le != hipSuccess) fprintf(stderr, "kernel_launch: launch failed: %s\n", hipGetErrorName(le));
}
```

```cpp
#include <hip/hip_runtime.h>
#include <cstdio>
#include <cstdint>
#include <cmath>
namespace pg8 {
#define PG8_LAS __attribute__((address_space(3)))
typedef unsigned short bf16_t;
typedef short bf16x8 __attribute__((ext_vector_type(8)));
typedef float f32x4 __attribute__((ext_vector_type(4)));
typedef float f32x2 __attribute__((ext_vector_type(2)));
typedef unsigned u32x4 __attribute__((ext_vector_type(4)));
constexpr int BM = 256, BK = 64, HALF = 128, HTB = HALF * BK * 2  , STAGE_BYTES = 8 * HTB, NXCD = 8, WGM = 8;

__host__ __device__ __forceinline__ int lds_byte(int r, int c) { const int st = (r >> 4) * 2 + (c >> 5), rr = r & 15, cc = c & 31, ob = rr * 64 + cc * 2; return st * 1024 + (ob ^ (((ob >> 9) & 1) << 5)); }
__host__ __device__ __forceinline__ void stage_rc(int b, int& R, int& C) { const int st = b / 1024, sb = b % 1024, swz = sb ^ (((sb >> 9) & 1) << 5); R = (st >> 1) * 16 + swz / 64; C = (st & 1) * 32 + (swz % 64) / 2; }
__host__ __device__ __forceinline__ int perm32(int rho) { const int n = rho >> 4, i = rho & 15; return 8 * (i >> 2) + 4 * n + (i & 3); }

struct Unit { int pm, pn, pz; };
struct Gemm { const bf16_t* A; const bf16_t* Bt; int M, N, K, lda, ldb; size_t zA, zB; };

struct StaticOrder {
    int nM, nN, nwg, G, c, Z;
    __host__ __device__ void init(int M, int N, int G_, int c_, int Z_ = 1) { nM = M / BM; nN = N / BM; nwg = nM * nN; G = G_; c = c_; Z = Z_; }
    __host__ __device__ bool next(int i, Unit& u) const {
        const long L = (long)(i / Z) * G + c; if (L >= nwg) return false;
        int wgid = (int)L; { const int q = nwg / NXCD, r = nwg % NXCD, xcd = wgid % NXCD, off = wgid / NXCD; wgid = (xcd < r ? xcd * (q + 1) : r * (q + 1) + (xcd - r) * q) + off; }
        const int nig = WGM * nN, gid = wgid / nig, fm = gid * WGM, gsz = (nM - fm) < WGM ? (nM - fm) : WGM;
        u.pm = fm + ((wgid % nig) % gsz); u.pn = (wgid % nig) / gsz; u.pz = i % Z; return true;
    }
    __device__ __forceinline__ void a_ready(const Unit&) const {}
    __device__ __forceinline__ void done(const Unit&) const {}
};

typedef __bf16 bf16x2_t __attribute__((ext_vector_type(2)));
__device__ __forceinline__ unsigned cvt_pk_bf16(float lo, float hi) { f32x2 v = {lo, hi}; bf16x2_t b = __builtin_convertvector(v, bf16x2_t); return __builtin_bit_cast(unsigned, b); }
__device__ __forceinline__ float bfl(unsigned w) { return __uint_as_float(w << 16); }
__device__ __forceinline__ float bfh(unsigned w) { return __uint_as_float(w & 0xffff0000u); }
__device__ __forceinline__ float fsigmoid(float x) { return __builtin_amdgcn_rcpf(1.0f + __builtin_amdgcn_exp2f(-1.4426950408889634f * x)); }

struct EpiBf16 {
    static constexpr bool PERM = true, AFTER_DRAIN = false;
    bf16_t* O; int ldc;
    __device__ __forceinline__ void operator()(const f32x4 (&acc)[2][2][4][2], const Unit& u, int wr, int wc, int fr, int fq) const {
        const int row0 = u.pm * BM + wr * 64 + fr, col0 = u.pn * BM + wc * 32 + 8 * fq;
#pragma unroll
        for (int ai = 0; ai < 2; ++ai)
#pragma unroll
            for (int m = 0; m < 4; ++m) { bf16_t* rowp = O + (size_t)(row0 + ai * HALF + m * 16) * ldc + col0;
#pragma unroll
                for (int bj = 0; bj < 2; ++bj) { const f32x4 v0 = acc[ai][bj][m][0], v1 = acc[ai][bj][m][1];
                    u32x4 w; w.x = cvt_pk_bf16(v0[0], v0[1]); w.y = cvt_pk_bf16(v0[2], v0[3]); w.z = cvt_pk_bf16(v1[0], v1[1]); w.w = cvt_pk_bf16(v1[2], v1[3]);
                    *(u32x4*)(rowp + bj * HALF) = w; } }
    }
};
struct EpiSwiglu {
    static constexpr bool PERM = true, AFTER_DRAIN = false;
    bf16_t* O; int ldc; float* nanp;
    __device__ __forceinline__ void operator()(const f32x4 (&acc)[2][2][4][2], const Unit& u, int wr, int wc, int fr, int fq) const {
        const int row0 = u.pm * BM + wr * 64 + fr, col0 = u.pn * HALF + wc * 32 + 8 * fq;
#pragma unroll
        for (int ai = 0; ai < 2; ++ai)
#pragma unroll
            for (int m = 0; m < 4; ++m) { bf16_t* rowp = O + (size_t)(row0 + ai * HALF + m * 16) * ldc + col0;
                float r[8];
#pragma unroll
                for (int n = 0; n < 2; ++n)
#pragma unroll
                    for (int j = 0; j < 4; ++j) { const float gt = acc[ai][0][m][n][j], up = acc[ai][1][m][n][j]; r[n * 4 + j] = gt * fsigmoid(gt) * up; }
                u32x4 w; w.x = cvt_pk_bf16(r[0], r[1]); w.y = cvt_pk_bf16(r[2], r[3]); w.z = cvt_pk_bf16(r[4], r[5]); w.w = cvt_pk_bf16(r[6], r[7]);
                if (nanp) { const u32x4 o = *(const u32x4*)rowp; if (o.x != w.x || o.y != w.y || o.z != w.z || o.w != w.w) *nanp = __builtin_nanf(""); } else *(u32x4*)rowp = w; }
    }
};
struct EpiResidual {
    static constexpr bool PERM = false, AFTER_DRAIN = false;
    const float* base; float* out; int ldc; float alpha, s;
    __device__ __forceinline__ void operator()(const f32x4 (&acc)[2][2][4][2], const Unit& u, int wr, int wc, int fr, int fq) const {
        const int row0 = u.pm * BM + wr * 64 + fr, col0 = u.pn * BM + wc * 32 + 4 * fq;
        const float* __restrict__ bp = base; float* __restrict__ op = out;
#pragma unroll
        for (int ai = 0; ai < 2; ++ai) {
            f32x4 bs[4][2][2];
#pragma unroll
            for (int m = 0; m < 4; ++m) { const size_t off = (size_t)(row0 + ai * HALF + m * 16) * ldc + col0;
#pragma unroll
                for (int bj = 0; bj < 2; ++bj)
#pragma unroll
                    for (int n = 0; n < 2; ++n) bs[m][bj][n] = *(const f32x4*)(bp + off + bj * HALF + n * 16); }
#pragma unroll
            for (int m = 0; m < 4; ++m) { const size_t off = (size_t)(row0 + ai * HALF + m * 16) * ldc + col0;
#pragma unroll
                for (int bj = 0; bj < 2; ++bj)
#pragma unroll
                    for (int n = 0; n < 2; ++n) *(f32x4*)(op + off + bj * HALF + n * 16) = bs[m][bj][n] * alpha + acc[ai][bj][m][n] * s; }
        }
    }
};
struct EpiWin {
    static constexpr bool PERM = true, AFTER_DRAIN = false;
    bf16_t* proj; int ldp; int npt; bf16_t* gates; int ldg; const float* bias; unsigned* nanp;
    __device__ __forceinline__ void put(bf16_t* dst, u32x4 w) const {
        if (nanp) { const u32x4 o = *(const u32x4*)dst; if (o.x != w.x || o.y != w.y || o.z != w.z || o.w != w.w) *nanp = 1u; } else *(u32x4*)dst = w; }
    __device__ __forceinline__ void operator()(const f32x4 (&acc)[2][2][4][2], const Unit& u, int wr, int wc, int fr, int fq) const {
        const int row0 = u.pm * BM + wr * 64 + fr;
        if (u.pn < npt) {
            const int col0 = u.pn * BM + wc * 32 + 8 * fq;
#pragma unroll
            for (int ai = 0; ai < 2; ++ai)
#pragma unroll
                for (int m = 0; m < 4; ++m) { bf16_t* rowp = proj + (size_t)(row0 + ai * HALF + m * 16) * ldp + col0;
#pragma unroll
                    for (int bj = 0; bj < 2; ++bj) { const f32x4 v0 = acc[ai][bj][m][0], v1 = acc[ai][bj][m][1];
                        u32x4 w; w.x = cvt_pk_bf16(v0[0], v0[1]); w.y = cvt_pk_bf16(v0[2], v0[3]); w.z = cvt_pk_bf16(v1[0], v1[1]); w.w = cvt_pk_bf16(v1[2], v1[3]);
                        put(rowp + bj * HALF, w); } }
        } else {
            const int col0 = (u.pn - npt) * BM + wc * 32 + 8 * fq;
            f32x4 bv[2][2];
#pragma unroll
            for (int bj = 0; bj < 2; ++bj)
#pragma unroll
                for (int n = 0; n < 2; ++n) bv[bj][n] = *(const f32x4*)(bias + col0 + bj * HALF + 4 * n);
#pragma unroll
            for (int ai = 0; ai < 2; ++ai)
#pragma unroll
                for (int m = 0; m < 4; ++m) { bf16_t* rowp = gates + (size_t)(row0 + ai * HALF + m * 16) * ldg + col0;
#pragma unroll
                    for (int bj = 0; bj < 2; ++bj) { f32x4 v0 = acc[ai][bj][m][0] + bv[bj][0], v1 = acc[ai][bj][m][1] + bv[bj][1];
#pragma unroll
                        for (int j = 0; j < 4; ++j) { v0[j] = fsigmoid(v0[j]); v1[j] = fsigmoid(v1[j]); }
                        u32x4 w; w.x = cvt_pk_bf16(v0[0], v0[1]); w.y = cvt_pk_bf16(v0[2], v0[3]); w.z = cvt_pk_bf16(v1[0], v1[1]); w.w = cvt_pk_bf16(v1[2], v1[3]);
                        put(rowp + bj * HALF, w); } }
        }
    }
};
struct EpiMerge {
    static constexpr bool PERM = true, AFTER_DRAIN = false;
    bf16_t* merged; int ldc; const bf16_t* gates; int ldg;
    __device__ __forceinline__ void operator()(const f32x4 (&acc)[2][2][4][2], const Unit& u, int wr, int wc, int fr, int fq) const {
        const int row0 = u.pm * BM + wr * 64 + fr, col0 = u.pn * BM + wc * 32 + 8 * fq;
        const bf16_t* __restrict__ gp = gates + (size_t)u.pz * ldc + col0; const bf16_t* __restrict__ mp = merged + col0; bf16_t* __restrict__ op = merged + col0;
#pragma unroll
        for (int ai = 0; ai < 2; ++ai) {
            u32x4 g[4][2], pv[4][2];
#pragma unroll
            for (int m = 0; m < 4; ++m) { const size_t row = (size_t)(row0 + ai * HALF + m * 16);
#pragma unroll
                for (int bj = 0; bj < 2; ++bj) { g[m][bj] = *(const u32x4*)(gp + row * ldg + bj * HALF); pv[m][bj] = (u32x4){0u, 0u, 0u, 0u}; if (u.pz > 0) pv[m][bj] = *(const u32x4*)(mp + row * ldc + bj * HALF); } }
#pragma unroll
            for (int m = 0; m < 4; ++m) { const size_t row = (size_t)(row0 + ai * HALF + m * 16);
#pragma unroll
                for (int bj = 0; bj < 2; ++bj) { const f32x4 v0 = acc[ai][bj][m][0], v1 = acc[ai][bj][m][1]; const u32x4 gg = g[m][bj], pp = pv[m][bj];
                    u32x4 w;
                    w.x = cvt_pk_bf16(bfl(pp.x) + bfl(gg.x) * v0[0], bfh(pp.x) + bfh(gg.x) * v0[1]);
                    w.y = cvt_pk_bf16(bfl(pp.y) + bfl(gg.y) * v0[2], bfh(pp.y) + bfh(gg.y) * v0[3]);
                    w.z = cvt_pk_bf16(bfl(pp.z) + bfl(gg.z) * v1[0], bfh(pp.z) + bfh(gg.z) * v1[1]);
                    w.w = cvt_pk_bf16(bfl(pp.w) + bfl(gg.w) * v1[2], bfh(pp.w) + bfh(gg.w) * v1[3]);
                    *(u32x4*)(op + row * ldc + bj * HALF) = w; } }
        }
    }
};

template <class Epi, class Sched, bool ALIGN_EPI = false, bool SP2 = false>
__device__ __forceinline__ void gemm_phase(PG8_LAS unsigned char* lds, const Gemm g, const Sched& S, const Epi& E, int tid_in) {
    int tid_ = tid_in; asm volatile("" : "+v"(tid_));
    const int tid = tid_, wid = __builtin_amdgcn_readfirstlane(tid >> 6), lane = tid & 63, wr = wid >> 2, wc = wid & 3, fr = lane & 15, fq = lane >> 4;
    const int K = g.K, nt = K / BK;
    unsigned voffA[2], voffB[2];
#pragma unroll
    for (int i = 0; i < 2; ++i) { int R, C; stage_rc(tid * 16 + i * 8192, R, C); const int Rb = Epi::PERM ? ((R & ~31) + perm32(R & 31)) : R;
        voffA[i] = (unsigned)(R * g.lda + C) * 2u; voffB[i] = (unsigned)(Rb * g.ldb + C) * 2u; }
    const size_t kstep = (size_t)(BK * 2);
    const size_t hstepA = (size_t)HALF * g.lda * 2, hstepB = (size_t)HALF * g.ldb * 2;
    const size_t tstepA = 2 * hstepA, tstepB = 2 * hstepB;
    const unsigned ldsw = (unsigned)wid * 1024u;
    const int aoff = lds_byte(wr * 64 + fr, fq * 8), boff = lds_byte(wc * 32 + fr, fq * 8);
#define PG8_SA(b, h) (((b) * 2 + (h)) * HTB)
#define PG8_SB(b, h) ((4 + (b) * 2 + (h)) * HTB)
#define PG8_STAGE(bufoff, gbase, voff) do { _Pragma("unroll") for (int _i = 0; _i < 2; ++_i) \
        __builtin_amdgcn_global_load_lds((const unsigned*)((const char*)(gbase) + (voff)[_i]), (PG8_LAS unsigned*)(lds + (bufoff) + ldsw + _i * 8192), 16, 0, 0); } while (0)
#define PG8_LDA(dst, b, h) do { _Pragma("unroll") for (int m = 0; m < 4; ++m) _Pragma("unroll") for (int k = 0; k < 2; ++k) dst[m][k] = *(const PG8_LAS bf16x8*)(lds + PG8_SA(b, h) + aoff + m * 2048 + k * 1024); } while (0)
#define PG8_LDB(dst, b, h) do { _Pragma("unroll") for (int n = 0; n < 2; ++n) _Pragma("unroll") for (int k = 0; k < 2; ++k) dst[n][k] = *(const PG8_LAS bf16x8*)(lds + PG8_SB(b, h) + boff + n * 2048 + k * 1024); } while (0)
#define PG8_MMA(ai, bj, At, Bt) do { __builtin_amdgcn_s_setprio(1); _Pragma("unroll") for (int m = 0; m < 4; ++m) _Pragma("unroll") for (int n = 0; n < 2; ++n) _Pragma("unroll") for (int k = 0; k < 2; ++k) \
        acc[ai][bj][m][n] = __builtin_amdgcn_mfma_f32_16x16x32_bf16(Bt[n][k], At[m][k], acc[ai][bj][m][n], 0, 0, 0); __builtin_amdgcn_s_setprio(0); } while (0)
#define PG8_WAIT_V(n) asm volatile("s_waitcnt vmcnt(" #n ")" ::: "memory")
#ifdef DBG_VM0
#define PG8_WAIT_VK PG8_WAIT_V(0)
#else
#define PG8_WAIT_VK PG8_WAIT_V(8)
#endif
#define PG8_WAIT_L(n) asm volatile("s_waitcnt lgkmcnt(" #n ")" ::: "memory")
#define PG8_BAR __builtin_amdgcn_s_barrier()
#define PG8_SCHED __builtin_amdgcn_sched_barrier(0)
    Unit cur, nxt; int ui = 0;
    if (!S.next(0, cur)) return;
    f32x4 acc[2][2][4][2];
#pragma unroll
    for (int a = 0; a < 2; ++a)
#pragma unroll
        for (int b = 0; b < 2; ++b)
#pragma unroll
            for (int m = 0; m < 4; ++m)
#pragma unroll
                for (int n = 0; n < 2; ++n) acc[a][b][m][n] = (f32x4){0.f, 0.f, 0.f, 0.f};
    bf16x8 At[4][2], B0[2][2], B1[2][2];
    const char* cA = (const char*)g.A + (size_t)cur.pm * tstepA + (size_t)cur.pz * g.zA; const char* cB = (const char*)g.Bt + (size_t)cur.pn * tstepB + (size_t)cur.pz * g.zB;
    S.a_ready(cur);
    if constexpr (SP2) {
        PG8_STAGE(PG8_SB(0, 0), cB, voffB); PG8_STAGE(PG8_SB(0, 1), cB + hstepB, voffB); PG8_STAGE(PG8_SA(0, 0), cA, voffA); PG8_STAGE(PG8_SA(0, 1), cA + hstepA, voffA);
        if (wr == 1) PG8_BAR;
        PG8_WAIT_V(2); PG8_BAR;
        PG8_STAGE(PG8_SB(1, 0), cB + kstep, voffB); PG8_STAGE(PG8_SA(1, 0), cA + kstep, voffA); PG8_STAGE(PG8_SB(1, 1), cB + hstepB + kstep, voffB);
        PG8_WAIT_V(6); PG8_BAR;
    } else {
        PG8_STAGE(PG8_SB(0, 0), cB, voffB); PG8_STAGE(PG8_SA(0, 0), cA, voffA); PG8_STAGE(PG8_SB(0, 1), cB + hstepB, voffB); PG8_STAGE(PG8_SA(0, 1), cA + hstepA, voffA);
        if (wr == 1) PG8_BAR;
        PG8_WAIT_V(4); PG8_BAR;
        PG8_STAGE(PG8_SB(1, 0), cB + kstep, voffB); PG8_STAGE(PG8_SA(1, 0), cA + kstep, voffA); PG8_STAGE(PG8_SB(1, 1), cB + hstepB + kstep, voffB);
        PG8_WAIT_V(6); PG8_BAR;
    }
    for (;;) {
        const bool has_next = S.next(ui + 1, nxt);
        const char* nA = has_next ? (const char*)g.A + (size_t)nxt.pm * tstepA + (size_t)nxt.pz * g.zA : cA; const char* nB = has_next ? (const char*)g.Bt + (size_t)nxt.pn * tstepB + (size_t)nxt.pz * g.zB : cB;
        for (int t = 0; t < nt; t += 2) {
            const bool last = (t == nt - 2);
            const char* a1 = cA + (size_t)(t + 1) * kstep;
            const char* a2 = last ? nA : cA + (size_t)(t + 2) * kstep; const char* b2 = last ? nB : cB + (size_t)(t + 2) * kstep;
            const char* a3 = a2 + kstep; const char* b3 = b2 + kstep;
            if (last && has_next) S.a_ready(nxt);
            if constexpr (SP2) {
            PG8_LDB(B0, 0, 0); PG8_LDB(B1, 0, 1); PG8_SCHED; PG8_LDA(At, 0, 0); PG8_STAGE(PG8_SA(1, 1), a1 + hstepA, voffA);
            PG8_WAIT_VK; PG8_WAIT_L(0); PG8_BAR; PG8_MMA(0, 0, At, B0); PG8_MMA(0, 1, At, B1); PG8_BAR; PG8_SCHED;
            PG8_LDA(At, 0, 1); PG8_STAGE(PG8_SB(0, 0), b2, voffB); PG8_STAGE(PG8_SB(0, 1), b2 + hstepB, voffB); PG8_STAGE(PG8_SA(0, 0), a2, voffA);
            PG8_WAIT_VK; PG8_WAIT_L(0); PG8_BAR; PG8_MMA(1, 0, At, B0); PG8_MMA(1, 1, At, B1); PG8_BAR; PG8_SCHED;
            PG8_LDB(B0, 1, 0); PG8_LDB(B1, 1, 1); PG8_SCHED; PG8_LDA(At, 1, 0); PG8_STAGE(PG8_SA(0, 1), a2 + hstepA, voffA);
            PG8_WAIT_VK; PG8_WAIT_L(0); PG8_BAR; PG8_MMA(0, 0, At, B0); PG8_MMA(0, 1, At, B1); PG8_BAR; PG8_SCHED;
            PG8_LDA(At, 1, 1); PG8_STAGE(PG8_SB(1, 0), b3, voffB); PG8_STAGE(PG8_SB(1, 1), b3 + hstepB, voffB); PG8_STAGE(PG8_SA(1, 0), a3, voffA);
            PG8_WAIT_VK; PG8_WAIT_L(0); PG8_BAR; PG8_MMA(1, 0, At, B0); PG8_MMA(1, 1, At, B1); PG8_BAR; PG8_SCHED;
            } else {
            PG8_LDB(B0, 0, 0); PG8_SCHED; PG8_LDA(At, 0, 0); PG8_STAGE(PG8_SA(1, 1), a1 + hstepA, voffA);
            PG8_WAIT_L(8); PG8_BAR; PG8_WAIT_L(0); PG8_MMA(0, 0, At, B0); PG8_BAR; PG8_SCHED;
            PG8_LDB(B1, 0, 1); PG8_STAGE(PG8_SB(0, 0), b2, voffB);
            PG8_BAR; PG8_WAIT_L(0); PG8_MMA(0, 1, At, B1); PG8_BAR;
            PG8_LDA(At, 0, 1); PG8_STAGE(PG8_SA(0, 0), a2, voffA);
            PG8_BAR; PG8_WAIT_L(0); PG8_MMA(1, 0, At, B0); PG8_BAR; PG8_SCHED;
            PG8_STAGE(PG8_SB(0, 1), b2 + hstepB, voffB);
            PG8_WAIT_V(6); PG8_BAR; PG8_MMA(1, 1, At, B1); PG8_BAR;
            PG8_LDB(B0, 1, 0); PG8_SCHED; PG8_LDA(At, 1, 0); PG8_STAGE(PG8_SA(0, 1), a2 + hstepA, voffA);
            PG8_WAIT_L(8); PG8_BAR; PG8_WAIT_L(0); PG8_MMA(0, 0, At, B0); PG8_BAR; PG8_SCHED;
            PG8_LDB(B1, 1, 1); PG8_STAGE(PG8_SB(1, 0), b3, voffB);
            PG8_BAR; PG8_WAIT_L(0); PG8_MMA(0, 1, At, B1); PG8_BAR;
            PG8_LDA(At, 1, 1); PG8_STAGE(PG8_SA(1, 0), a3, voffA);
            PG8_BAR; PG8_WAIT_L(0); PG8_MMA(1, 0, At, B0); PG8_BAR; PG8_SCHED;
            PG8_STAGE(PG8_SB(1, 1), b3 + hstepB, voffB);
            PG8_WAIT_V(6); PG8_BAR; PG8_MMA(1, 1, At, B1); PG8_BAR;
            }
        }
        if constexpr (ALIGN_EPI) { if (wr == 0) PG8_BAR; }
        if constexpr (!Epi::AFTER_DRAIN) { E(acc, cur, wr, wc, fr, fq); S.done(cur); }
        if (!has_next) break;
#pragma unroll
        for (int a = 0; a < 2; ++a)
#pragma unroll
            for (int b = 0; b < 2; ++b)
#pragma unroll
                for (int m = 0; m < 4; ++m)
#pragma unroll
                    for (int n = 0; n < 2; ++n) acc[a][b][m][n] = (f32x4){0.f, 0.f, 0.f, 0.f};
        cur = nxt; cA = nA; cB = nB; ++ui;
        if constexpr (ALIGN_EPI) { if (wr == 1) PG8_BAR; }
    }
    PG8_WAIT_V(0);
    if constexpr (!ALIGN_EPI) { if (wr == 0) PG8_BAR; }
    PG8_BAR;
    if constexpr (Epi::AFTER_DRAIN) { E.fused(acc, cur, wr, wc, fr, fq, lds, wid, lane); S.done(cur); }
#undef PG8_SA
#undef PG8_SB
#undef PG8_STAGE
#undef PG8_LDA
#undef PG8_LDB
#undef PG8_MMA
#undef PG8_WAIT_V
#undef PG8_WAIT_L
#undef PG8_BAR
#undef PG8_SCHED
}
}
#define GAS __attribute__((address_space(1)))
#define LAS __attribute__((address_space(3)))
typedef unsigned short bf16;
typedef unsigned v4u __attribute__((ext_vector_type(4)));
typedef float f32x4 __attribute__((ext_vector_type(4)));
typedef short bf16x8 __attribute__((ext_vector_type(8)));
typedef GAS unsigned gu32;
typedef GAS unsigned long long gu64;
#define RLX_AGENT __ATOMIC_RELAXED, __HIP_MEMORY_SCOPE_AGENT
#define LDS_WAIT() asm volatile("s_waitcnt lgkmcnt(0)" ::: "memory")
#define VM_WAIT() asm volatile("s_waitcnt vmcnt(0)" ::: "memory")
__device__ __forceinline__ unsigned long long rt() { return __builtin_amdgcn_s_memrealtime(); }
__device__ __forceinline__ unsigned f2bf(float f) { unsigned u = __builtin_bit_cast(unsigned, f); return (u + 0x7fffu + ((u >> 16) & 1u)) >> 16; }
__device__ __forceinline__ unsigned pk2(float lo, float hi) { return f2bf(lo) | (f2bf(hi) << 16); }

#define XB_TMO      128
#define XB_XCNT(j)  (256  + 64 * (j))
#define XB_XSUB(j)  (1280 + 64 * (j))
#define XB_XGEN(j)  (2304 + 64 * (j))
#define XB_TOP      3328
#define XB_TOPGEN   3392
#define XCD_BAR_WORDS 3456
#define XB_SPIN_CAP (1u << 18)

__device__ __forceinline__ unsigned xb_ld(unsigned* p)              { return __hip_atomic_load(p, __ATOMIC_RELAXED, __HIP_MEMORY_SCOPE_AGENT); }
__device__ __forceinline__ unsigned xb_add(unsigned* p, unsigned v) { return __hip_atomic_fetch_add(p, v, __ATOMIC_RELAXED, __HIP_MEMORY_SCOPE_AGENT); }
__device__ __forceinline__ unsigned xb_xcc_id() { return (unsigned)__builtin_amdgcn_s_getreg((3 << 11) | 20) & 0xFu; }
#define XB_SPIN(cond, bar) do { unsigned _sp = 0; while (cond) { __builtin_amdgcn_s_sleep(1); \
    if ((++_sp & 255u) == 0u) { if (xb_ld(&(bar)[XB_TMO])) break; if (_sp > XB_SPIN_CAP) { atomicAdd(&(bar)[XB_TMO], 1u); break; } } } } while (0)

__device__ __forceinline__ unsigned xb_lane() { unsigned z = 0u; asm volatile("" : "+s"(z)); return __builtin_amdgcn_mbcnt_hi(~0u, __builtin_amdgcn_mbcnt_lo(~0u, z)); }
__device__ __forceinline__ bool xb_thread0(int wave) { return wave == 0 && xb_lane() == 0u; }
struct XcdBarrier {
    unsigned* bar; unsigned x; int wave;
    volatile LAS unsigned* st;
};

__device__ __forceinline__ XcdBarrier xcd_barrier_post(unsigned* bar, volatile LAS unsigned* st, int wave) {
    XcdBarrier b; b.bar = bar; b.x = xb_xcc_id(); b.st = st; b.wave = wave;
    if (xb_thread0(wave)) (void)xb_add(&bar[XB_XCNT(b.x)], 1u);
    return b;
}
__device__ __forceinline__ void xcd_barrier_complete(unsigned* bar, unsigned x, unsigned& nloc, unsigned& nx) {
    const unsigned G = gridDim.x * gridDim.y * gridDim.z;
    unsigned sum, cnt, mine, sp = 0u;
    for (;;) {
        sum = 0u; cnt = 0u; mine = 0u;
#pragma unroll
        for (unsigned j = 0; j < 16; ++j) { const unsigned c = xb_ld(&bar[XB_XCNT(j)]); sum += c; cnt += (c > 0u) ? 1u : 0u; mine = (j == x) ? c : mine; }
        if (sum == G) break;
        __builtin_amdgcn_s_sleep(1);
        if ((++sp & 255u) == 0u) { if (xb_ld(&bar[XB_TMO])) break; if (sp > XB_SPIN_CAP) { atomicAdd(&bar[XB_TMO], 1u); break; } }
    }
    nloc = mine > 0u ? mine : 1u; nx = cnt > 0u ? cnt : 1u;
}

__device__ __forceinline__ void xcd_barrier(const XcdBarrier& b) {
    asm volatile("s_waitcnt vmcnt(0)" ::: "memory");
    __syncthreads();
    if (xb_thread0(b.wave)) {
        unsigned* bar = b.bar;
        __builtin_amdgcn_s_waitcnt(0);
        unsigned nloc = b.st[0], nx = b.st[1];
        if (nloc == 0u) { xcd_barrier_complete(bar, b.x, nloc, nx); b.st[0] = nloc; b.st[1] = nx; }
        const unsigned old = xb_add(&bar[XB_XSUB(b.x)], 1u);
        const unsigned gen = old / nloc;
        if (old + 1u == (gen + 1u) * nloc) {
            __builtin_amdgcn_fence(__ATOMIC_RELEASE, "agent");
            asm volatile("s_waitcnt vmcnt(0)" ::: "memory");
            const unsigned og = xb_add(&bar[XB_TOP], 1u);
            const unsigned tg = og / nx;
            if (og + 1u == (tg + 1u) * nx) xb_add(&bar[XB_TOPGEN], 1u);
            else XB_SPIN(xb_ld(&bar[XB_TOPGEN]) == tg, bar);
            __builtin_amdgcn_fence(__ATOMIC_ACQUIRE, "agent");
            xb_add(&bar[XB_XGEN(b.x)], 1u);
            asm volatile("s_waitcnt vmcnt(0)" ::: "memory");
        } else {
            XB_SPIN(xb_ld(&bar[XB_XGEN(b.x)]) == gen, bar);
            __builtin_amdgcn_fence(__ATOMIC_ACQUIRE, "agent");
            asm volatile("s_waitcnt vmcnt(0)" ::: "memory");
        }
    }
    __syncthreads();
}

#define DBG_LAYERS 4
#define DBG_SUBS 3

constexpr int DM = 2048, BATCH = 16, SEQ = 2048, DEPTH = 4, MTOK = BATCH * SEQ;
constexpr int DFF = 5632, NIN = 13400;
constexpr int PROJ_LD = 5376, NPT = 21, NWIN = 13568, GATE_LD = 8192;
constexpr float NORM_EPS = 1e-5f;
constexpr float ALPHA = 1.681792830507429f;
constexpr int PA_Q = 0, PA_K = 512, PA_V = 1024, PB_Q = 1536, PB_K = 1792, PB_V = 2048, PB_R = 2560, PC_Q = 3072, PC_KV = 3456, PD_Z = 3584, PD_XBC = 4096, PC_KR = 5120, PB_GLOW = 5184, PD_DT = 5200;
constexpr size_t MiB = 1u << 20;
constexpr size_t WS_CTL = 0, CTL_ZERO_BYTES = 1 * MiB;
constexpr size_t WS_ROPE = 1 * MiB;
constexpr size_t WS_WGU0 = 11 * MiB, WS_WD0 = 55 * MiB, WS_WGU1 = 77 * MiB, WS_WD1 = 121 * MiB, WS_WIN = 143 * MiB, WS_WB = 196 * MiB, WS_WO = 204 * MiB, WS_WUQ = 212 * MiB, WS_WUKV = 213 * MiB;
constexpr size_t WS_HB = 214 * MiB;
constexpr size_t WS_MIX = 342 * MiB;
constexpr size_t WS_ACT = WS_MIX;
constexpr size_t WS_PROJ = WS_MIX;
constexpr size_t WS_MERGED = WS_MIX;
constexpr size_t WS_GATES = WS_MIX + 336 * MiB;
constexpr size_t WS_OBR = WS_GATES + 512 * MiB;
constexpr size_t WS_QM = WS_OBR + 128 * MiB;
constexpr size_t WS_KVM = WS_QM + 48 * MiB;
constexpr size_t WS_CQN = WS_KVM + 64 * MiB;
constexpr size_t WS_CKVN = WS_CQN + 24 * MiB;
constexpr size_t WS_KROPE = WS_CKVN + 16 * MiB;
constexpr size_t WS_XBC = WS_KROPE + 4 * MiB;
constexpr size_t WS_DT = WS_XBC + 64 * MiB;
constexpr size_t WS_RAWA = WS_DT + 1 * MiB;
constexpr size_t WS_RAWB = WS_RAWA + 128 * MiB;
constexpr size_t WS_RAWD = WS_RAWB + 64 * MiB;
constexpr size_t WS_GQT = WS_RAWD + 64 * MiB, WS_GKT = WS_GQT + 16 * MiB, WS_GKD = WS_GKT + 16 * MiB, WS_GEB = WS_GKD + 16 * MiB;
constexpr size_t WS_END = WS_GEB + 1 * MiB;
constexpr size_t WS_DUMMY = 700 * MiB;
static_assert(WS_END <= 1956000000ull, "workspace");
static_assert(WS_WD0 - WS_WGU0 >= (size_t)11264 * 2048 * 2 && WS_WGU1 - WS_WD0 >= (size_t)2048 * 5632 * 2 && WS_WB - WS_WIN >= (size_t)NWIN * 2048 * 2 && WS_WO - WS_WB >= (size_t)4 * 2048 * 512 * 2, "weights map");
constexpr int CW_BAR = 4096;
constexpr int LDS_BYTES = 147456, MISC_OFF = 131072 + 320;

typedef float f32x16 __attribute__((ext_vector_type(16)));
typedef short v4i16_t __attribute__((ext_vector_type(4)));
__device__ __forceinline__ int crow(int r, int hi) { return (r & 3) + 8 * (r >> 2) + 4 * hi; }
struct Params {
    const float* x; const int* pos; const float* ln_g; const float* ln_b;
    const float* w_gu[2]; const float* w_down[2]; const float* w_in; const float* b_gate;
    const float* diff_lambda; const float* diff_subln_g; const float* gla_w_gate2; const float* gla_b_gate; const float* gla_norm_g;
    const float* mla_q_norm_g; const float* mla_w_uq; const float* mla_kv_norm_g; const float* mla_w_ukv;
    const float* ssd_conv_w; const float* ssd_conv_b; const float* ssd_dt_bias; const float* ssd_a_log; const float* ssd_d; const float* ssd_norm_g;
    const float* w_branch; const float* w_out;
    float* out; unsigned char* ws;
    float lam_init[4]; float inv_d[8]; float inv_m[32];
};
typedef const __attribute__((address_space(4))) Params& PRM;
struct Ctx { LAS unsigned char* lds; int tid, lane, wave, G, bid; };

__device__ __forceinline__ float bf2f(bf16 v) { return __uint_as_float(((unsigned)v) << 16); }
__device__ __forceinline__ float wave_sum(float v) {
    v += __builtin_bit_cast(float, __builtin_amdgcn_ds_swizzle(__builtin_bit_cast(int, v), (1 << 10) | 0x1f));
    v += __builtin_bit_cast(float, __builtin_amdgcn_ds_swizzle(__builtin_bit_cast(int, v), (2 << 10) | 0x1f));
    v += __builtin_bit_cast(float, __builtin_amdgcn_ds_swizzle(__builtin_bit_cast(int, v), (4 << 10) | 0x1f));
    v += __builtin_bit_cast(float, __builtin_amdgcn_ds_swizzle(__builtin_bit_cast(int, v), (8 << 10) | 0x1f));
    v += __builtin_bit_cast(float, __builtin_amdgcn_ds_swizzle(__builtin_bit_cast(int, v), (16 << 10) | 0x1f));
    auto rr = __builtin_amdgcn_permlane32_swap(__float_as_uint(v), __float_as_uint(v), false, false);
    return __uint_as_float(rr[0]) + __uint_as_float(rr[1]);
}
__device__ __forceinline__ float silu_f(float x) { return x / (1.0f + __expf(-x)); }
__device__ __forceinline__ float log1p_01(float e) { const float s = e * (1.0f - e * (0.5f - e * (0.33333334f - 0.25f * e))); return e < 0.03125f ? s : __logf(1.0f + e); }
__device__ __forceinline__ float softplus_f(float x) { return fmaxf(x, 0.f) + log1p_01(__expf(-fabsf(x))); }
__device__ __forceinline__ float logsigmoid_f(float x) { return fminf(x, 0.f) - log1p_01(__expf(-fabsf(x))); }

__device__ __forceinline__ int src_col(int kind, int d) {
    if (kind == 0) { const int t = d >> 8, w = d & 255; return w < 128 ? t * 128 + w : DFF + t * 128 + (w - 128); }
    if (kind == 2) {
        if (d < 2560) return d;
        if (d < 3072) return 2576 + (d - 2560);
        if (d < 3456) return 3088 + (d - 3072);
        if (d < 3584) return 3472 + (d - 3456);
        if (d < 4096) return 3664 + (d - 3584);
        if (d < 5120) return 4176 + (d - 4096);
        if (d < 5184) return 3600 + (d - 5120);
        if (d < 5200) return 2560 + (d - 5184);
        if (d < 5208) return 5200 + (d - 5200);
        if (d < 5376) return -1;
        return 5208 + (d - 5376);
    }
    return d;
}
__device__ __forceinline__ void transpose_item64(const float* W, int K, int N, bf16* WT, int ldw, LAS unsigned char* tile, int rb, int kb, int lane, int kind) {
    const int k0 = 64 * kb, kr = lane >> 4, n4 = (lane & 15) * 4, src = src_col(kind, rb * 64 + n4);
    f32x4 v[16];
#pragma unroll
    for (int i = 0; i < 16; ++i) { const int k = k0 + kr + 4 * i; v[i] = (f32x4){0.f, 0.f, 0.f, 0.f}; if (src >= 0 && k < K) v[i] = *(const GAS f32x4*)(W + (size_t)k * N + src); }
#pragma unroll
    for (int i = 0; i < 16; ++i) *(LAS unsigned long long*)(tile + (kr + 4 * i) * 144 + n4 * 2) = (unsigned long long)pg8::cvt_pk_bf16(v[i].x, v[i].y) | ((unsigned long long)pg8::cvt_pk_bf16(v[i].z, v[i].w) << 32);
    LDS_WAIT(); asm volatile("" ::: "memory");
    const int hh = lane >> 5, q = (lane & 15) >> 2, pp = lane & 3, blk = (lane >> 4) & 1;
    const LAS unsigned char* ta = tile + (16 * blk + 4 * pp) * 2 + (q + 8 * hh) * 144;
#pragma unroll
    for (int n0 = 0; n0 < 64; n0 += 32)
#pragma unroll
        for (int kk = 0; kk < 64; kk += 16) {
            const v4i16_t lo = __builtin_amdgcn_ds_read_tr16_b64_v4i16((LAS v4i16_t*)(ta + n0 * 2 + kk * 144));
            const v4i16_t hi = __builtin_amdgcn_ds_read_tr16_b64_v4i16((LAS v4i16_t*)(ta + n0 * 2 + (kk + 4) * 144));
            const bf16x8 o = (bf16x8){lo[0], lo[1], lo[2], lo[3], hi[0], hi[1], hi[2], hi[3]};
            *(GAS bf16x8*)(WT + (size_t)(rb * 64 + n0 + (lane & 31)) * ldw + k0 + kk + 8 * hh) = o; }
    LDS_WAIT(); asm volatile("" ::: "memory");
}
__device__ __forceinline__ void ph_convert(PRM p, Ctx& c, int layer) {
    LAS unsigned char* tile = c.lds + c.wave * 16384;
    const int gw = c.bid * 8 + c.wave, NGW = c.G * 8;
    unsigned char* ws = p.ws;
    constexpr int I_GU = (11264 / 64) * (2048 / 64), I_DN = (2048 / 64) * (5632 / 64), I_WIN = (NWIN / 64) * 32, I_WB1 = 32 * 8, I_WO = 32 * 32, I_UQ = 12 * 6, I_UKV = 16 * 4;
    constexpr int TOT = 2 * (I_GU + I_DN) + I_WIN + 4 * I_WB1 + I_WO + I_UQ + I_UKV;
    for (int it = gw; it < TOT; it += NGW) {
        int r = it;
        if (r < 2 * I_GU) { const int f = r / I_GU; r -= f * I_GU; transpose_item64(p.w_gu[f] + (size_t)layer * 2048 * 11264, 2048, 11264, (bf16*)(ws + (f ? WS_WGU1 : WS_WGU0)), 2048, tile, r / 32, r % 32, c.lane, 0); continue; } r -= 2 * I_GU;
        if (r < 2 * I_DN) { const int f = r / I_DN; r -= f * I_DN; transpose_item64(p.w_down[f] + (size_t)layer * 5632 * 2048, 5632, 2048, (bf16*)(ws + (f ? WS_WD1 : WS_WD0)), 5632, tile, r / 88, r % 88, c.lane, 1); continue; } r -= 2 * I_DN;
        if (r < I_WIN) { transpose_item64(p.w_in + (size_t)layer * 2048 * NIN, 2048, NIN, (bf16*)(ws + WS_WIN), 2048, tile, r / 32, r % 32, c.lane, 2); continue; } r -= I_WIN;
        if (r < 4 * I_WB1) { const int z = r / I_WB1; r -= z * I_WB1; transpose_item64(p.w_branch + (size_t)(layer * 4 + z) * 512 * 2048, 512, 2048, (bf16*)(ws + WS_WB) + (size_t)z * 2048 * 512, 512, tile, r / 8, r % 8, c.lane, 1); continue; } r -= 4 * I_WB1;
        if (r < I_WO) { transpose_item64(p.w_out + (size_t)layer * 2048 * 2048, 2048, 2048, (bf16*)(ws + WS_WO), 2048, tile, r / 32, r % 32, c.lane, 1); continue; } r -= I_WO;
        if (r < I_UQ) { transpose_item64(p.mla_w_uq + (size_t)layer * 384 * 768, 384, 768, (bf16*)(ws + WS_WUQ), 384, tile, r / 6, r % 6, c.lane, 1); continue; } r -= I_UQ;
        transpose_item64(p.mla_w_ukv + (size_t)layer * 128 * 1024, 128, 1024, (bf16*)(ws + WS_WUKV), 256, tile, r / 4, r % 4, c.lane, 1);
    }
    if (layer == 0) {
        const size_t n8 = (size_t)MTOK * DM / 8; bf16* hb = (bf16*)(ws + WS_HB);
        for (size_t i = (size_t)c.bid * 512 + c.tid; i < n8; i += (size_t)c.G * 512) {
            const f32x4 a = *(const GAS f32x4*)(p.x + i * 8), b = *(const GAS f32x4*)(p.x + i * 8 + 4);
            v4u o; o.x = pk2(a.x, a.y); o.y = pk2(a.z, a.w); o.z = pk2(b.x, b.y); o.w = pk2(b.z, b.w);
            *(GAS v4u*)(hb + i * 8) = o; }
        { bf16* ck = (bf16*)(ws + WS_CKVN); unsigned z = 0u; asm volatile("" : "+v"(z)); const v4u zz = {z, z, z, z};
          for (int i = c.bid * 512 + c.tid; i < MTOK * 16; i += c.G * 512) *(GAS v4u*)(ck + (size_t)(i >> 4) * 256 + 128 + (i & 15) * 8) = zz; }
        float* cosd = (float*)(ws + WS_ROPE); float* sind = cosd + (size_t)MTOK * 8; float* cosm = sind + (size_t)MTOK * 8; float* sinm = cosm + (size_t)MTOK * 32;
        for (int i = c.bid * 512 + c.tid; i < MTOK * 40; i += c.G * 512) {
            const int row = i / 40, j = i % 40; const float ps = (float)p.pos[row];
            float sn, cs;
            if (j < 8) { const float ang = ps * p.inv_d[j]; sincosf(ang, &sn, &cs); cosd[row * 8 + j] = cs; sind[row * 8 + j] = sn; }
            else { const float ang = ps * p.inv_m[j - 8]; sincosf(ang, &sn, &cs); cosm[row * 32 + j - 8] = cs; sinm[row * 32 + j - 8] = sn; }
        }
    }
}

__device__ __forceinline__ void ph_ln(PRM p, Ctx& c, int layer, int sub, int rep = 0) {
    const float* g = p.ln_g + (size_t)(layer * 3 + sub) * DM; const float* bb = p.ln_b + (size_t)(layer * 3 + sub) * DM;
    bf16* hb = (bf16*)(p.ws + (rep ? WS_DUMMY + 256 * MiB : WS_HB)); float* hout = rep ? (float*)(p.ws + WS_DUMMY) : p.out;
    const int gw = c.bid * 8 + c.wave, NGW = c.G * 8;
    f32x4 gv[8], bv[8];
#pragma unroll
    for (int j = 0; j < 8; ++j) { gv[j] = *(const GAS f32x4*)(g + j * 256 + c.lane * 4); bv[j] = *(const GAS f32x4*)(bb + j * 256 + c.lane * 4); }
    for (int row = gw; row < MTOK; row += NGW) {
        float* hr = p.out + (size_t)row * DM;
        f32x4 v[8]; float s = 0.f;
#pragma unroll
        for (int j = 0; j < 8; ++j) { v[j] = *(const GAS f32x4*)(hr + j * 256 + c.lane * 4); s += (v[j].x + v[j].y) + (v[j].z + v[j].w); }
        const float mean = wave_sum(s) * (1.f / DM); float s2 = 0.f;
#pragma unroll
        for (int j = 0; j < 8; ++j) { v[j] = v[j] - mean; s2 += (v[j].x * v[j].x + v[j].y * v[j].y) + (v[j].z * v[j].z + v[j].w * v[j].w); }
        const float rstd = 1.0f / sqrtf(wave_sum(s2) * (1.f / DM) + NORM_EPS);
#pragma unroll
        for (int j = 0; j < 8; ++j) { const f32x4 o = v[j] * rstd * gv[j] + bv[j]; *(GAS f32x4*)(hout + (size_t)row * DM + j * 256 + c.lane * 4) = o;
            *(GAS unsigned long long*)(hb + (size_t)row * DM + j * 256 + c.lane * 4) = (unsigned long long)pk2(o.x, o.y) | ((unsigned long long)pk2(o.z, o.w) << 32); }
    }
}

__device__ __forceinline__ float sw_xor(float v, int m) { return v; }
__device__ __forceinline__ float group_sum16(float v) {
    v += __builtin_bit_cast(float, __builtin_amdgcn_ds_swizzle(__builtin_bit_cast(int, v), (1 << 10) | 0x1f));
    v += __builtin_bit_cast(float, __builtin_amdgcn_ds_swizzle(__builtin_bit_cast(int, v), (2 << 10) | 0x1f));
    v += __builtin_bit_cast(float, __builtin_amdgcn_ds_swizzle(__builtin_bit_cast(int, v), (4 << 10) | 0x1f));
    v += __builtin_bit_cast(float, __builtin_amdgcn_ds_swizzle(__builtin_bit_cast(int, v), (8 << 10) | 0x1f));
    return v; }
__device__ __forceinline__ float group_sum32(float v) { v = group_sum16(v); return v + __builtin_bit_cast(float, __builtin_amdgcn_ds_swizzle(__builtin_bit_cast(int, v), (16 << 10) | 0x1f)); }
__device__ __forceinline__ void unpack8(v4u w, float (&f)[8]) { f[0] = pg8::bfl(w.x); f[1] = pg8::bfh(w.x); f[2] = pg8::bfl(w.y); f[3] = pg8::bfh(w.y); f[4] = pg8::bfl(w.z); f[5] = pg8::bfh(w.z); f[6] = pg8::bfl(w.w); f[7] = pg8::bfh(w.w); }
__device__ __forceinline__ v4u pack8(const float (&f)[8]) { v4u w; w.x = pg8::cvt_pk_bf16(f[0], f[1]); w.y = pg8::cvt_pk_bf16(f[2], f[3]); w.z = pg8::cvt_pk_bf16(f[4], f[5]); w.w = pg8::cvt_pk_bf16(f[6], f[7]); return w; }
__device__ __forceinline__ void ph_prep(PRM p, Ctx& c, int layer, int rep = 0) {
    bf16* proj = (bf16*)(p.ws + WS_PROJ);
    bf16* cqn = (bf16*)(p.ws + WS_CQN); bf16* ckvn = (bf16*)(p.ws + WS_CKVN); bf16* krope = (bf16*)(p.ws + WS_KROPE); bf16* xbc = (bf16*)(p.ws + WS_XBC); float* dt = (float*)(p.ws + WS_DT);
    const float* cosd = (const float*)(p.ws + WS_ROPE); const float* sind = cosd + (size_t)MTOK * 8; const float* cosm = sind + (size_t)MTOK * 8; const float* sinm = cosm + (size_t)MTOK * 32;
    const int gw = c.bid * 8 + c.wave, NGW = c.G * 8, lane = c.lane;
    float cw[2][4][8], cb[2][8], ng[8];
    { const float* w = p.ssd_conv_w + layer * 4 * 1024; const float* bb = p.ssd_conv_b + layer * 1024;
#pragma unroll
      for (int u = 0; u < 2; ++u) { const int ch = 8 * (lane + 64 * u);
#pragma unroll
          for (int k = 0; k < 4; ++k) { const f32x4 a = *(const GAS f32x4*)(w + k * 1024 + ch), b2 = *(const GAS f32x4*)(w + k * 1024 + ch + 4);
              cw[u][k][0] = a.x; cw[u][k][1] = a.y; cw[u][k][2] = a.z; cw[u][k][3] = a.w; cw[u][k][4] = b2.x; cw[u][k][5] = b2.y; cw[u][k][6] = b2.z; cw[u][k][7] = b2.w; }
          const f32x4 a = *(const GAS f32x4*)(bb + ch), b2 = *(const GAS f32x4*)(bb + ch + 4);
          cb[u][0] = a.x; cb[u][1] = a.y; cb[u][2] = a.z; cb[u][3] = a.w; cb[u][4] = b2.x; cb[u][5] = b2.y; cb[u][6] = b2.z; cb[u][7] = b2.w; }
      const float* gsrc = lane < 48 ? p.mla_q_norm_g + layer * 384 + 8 * lane : p.mla_kv_norm_g + layer * 128 + 8 * (lane - 48);
      const f32x4 a = *(const GAS f32x4*)gsrc, b2 = *(const GAS f32x4*)(gsrc + 4);
      ng[0] = a.x; ng[1] = a.y; ng[2] = a.z; ng[3] = a.w; ng[4] = b2.x; ng[5] = b2.y; ng[6] = b2.z; ng[7] = b2.w; }
    for (int blk = gw; blk < MTOK / 16; blk += NGW) {
        const int row0 = blk * 16, t0 = row0 & (SEQ - 1);
        v4u win[2][3];
#pragma unroll
        for (int u = 0; u < 2; ++u)
#pragma unroll
            for (int k = 0; k < 3; ++k) { win[u][k] = (v4u){0u, 0u, 0u, 0u}; if (t0 - 3 + k >= 0) win[u][k] = *(const GAS v4u*)(proj + (size_t)(row0 - 3 + k) * PROJ_LD + PD_XBC + 8 * (lane + 64 * u)); }
        for (int rr = 0; rr < 16; ++rr) {
            const size_t row = (size_t)row0 + rr; bf16* pr = proj + row * PROJ_LD;
#pragma unroll
            for (int u = 0; u < 2; ++u) { const v4u xn = *(const GAS v4u*)(pr + PD_XBC + 8 * (lane + 64 * u));
                float x0[8], x1[8], x2[8], x3[8], o[8]; unpack8(win[u][0], x0); unpack8(win[u][1], x1); unpack8(win[u][2], x2); unpack8(xn, x3);
#pragma unroll
                for (int j = 0; j < 8; ++j) { const float a = cb[u][j] + cw[u][0][j] * x0[j] + cw[u][1][j] * x1[j] + cw[u][2][j] * x2[j] + cw[u][3][j] * x3[j]; o[j] = a * pg8::fsigmoid(a); }
                *(GAS v4u*)(xbc + row * 1024 + 8 * (lane + 64 * u)) = pack8(o);
                win[u][0] = win[u][1]; win[u][1] = win[u][2]; win[u][2] = xn; }
            { float x[8]; unpack8(*(const GAS v4u*)(pr + PC_Q + 8 * lane), x); float ss = 0.f;
#pragma unroll
              for (int j = 0; j < 8; ++j) ss += x[j] * x[j];
              const float sq = wave_sum(lane < 48 ? ss : 0.f), sk = wave_sum(lane < 48 ? 0.f : ss);
              const float rs = lane < 48 ? 1.0f / sqrtf(sq * (1.f / 384.f) + NORM_EPS) : 1.0f / sqrtf(sk * (1.f / 128.f) + NORM_EPS);
#pragma unroll
              for (int j = 0; j < 8; ++j) x[j] = x[j] * rs * ng[j];
              bf16* dst = lane < 48 ? cqn + row * 384 + 8 * lane : ckvn + row * 256 + 8 * (lane - 48);
              *(GAS v4u*)dst = pack8(x); }
            if (lane < 4) { float x1[8], x2[8], o1[8], o2[8]; unpack8(*(const GAS v4u*)(pr + PC_KR + 8 * lane), x1); unpack8(*(const GAS v4u*)(pr + PC_KR + 32 + 8 * lane), x2);
                const float* cs = cosm + row * 32 + 8 * lane; const float* sn = sinm + row * 32 + 8 * lane;
#pragma unroll
                for (int j = 0; j < 8; ++j) { o1[j] = x1[j] * cs[j] - x2[j] * sn[j]; o2[j] = x1[j] * sn[j] + x2[j] * cs[j]; }
                *(GAS v4u*)(krope + row * 64 + 8 * lane) = pack8(o1); *(GAS v4u*)(krope + row * 64 + 32 + 8 * lane) = pack8(o2); }
            else if (lane == 8) { float x[8]; unpack8(*(const GAS v4u*)(pr + PD_DT), x); const float* dtb = p.ssd_dt_bias + layer * 8;
#pragma unroll
                for (int j = 0; j < 8; ++j) x[j] = softplus_f(x[j] + dtb[j]);
                *(GAS f32x4*)(dt + row * 8) = (f32x4){x[0], x[1], x[2], x[3]}; *(GAS f32x4*)(dt + row * 8 + 4) = (f32x4){x[4], x[5], x[6], x[7]}; }
            else if (lane >= 16 && lane < 32 && !rep) { const int it = lane - 16; bf16* xb = pr + ((it >> 3) ? PA_K : PA_Q) + (it & 7) * 64;
                float x1[8], x2[8], o1[8], o2[8]; unpack8(*(const GAS v4u*)xb, x1); unpack8(*(const GAS v4u*)(xb + 8), x2);
                const float* cs = cosd + row * 8; const float* sn = sind + row * 8;
#pragma unroll
                for (int j = 0; j < 8; ++j) { o1[j] = x1[j] * cs[j] - x2[j] * sn[j]; o2[j] = x1[j] * sn[j] + x2[j] * cs[j]; }
                *(GAS v4u*)xb = pack8(o1); *(GAS v4u*)(xb + 8) = pack8(o2); }
        }
    }
}

template <int DK, bool MLA>
__device__ __forceinline__ void attn_naive_item(PRM p, Ctx& c, int inst, int qb) {
    const bf16* proj = (const bf16*)(p.ws + WS_PROJ); const bf16* qm = (const bf16*)(p.ws + WS_QM); const bf16* kvm = (const bf16*)(p.ws + WS_KVM); const bf16* krope = (const bf16*)(p.ws + WS_KROPE);
    const float* cosd = (const float*)(p.ws + WS_ROPE); const float* sind = cosd + (size_t)MTOK * 8; const float* cosm = sind + (size_t)MTOK * 8; const float* sinm = cosm + (size_t)MTOK * 32;
    const int r = c.tid >> 3, part = c.tid & 7;
    int b, h, m = 0; if (MLA) { b = inst >> 2; h = inst & 3; } else { m = inst & 1; h = (inst >> 1) & 3; b = inst >> 3; }
    const size_t rowbase = (size_t)b * SEQ; const size_t qrow = rowbase + qb * 64 + r;
    const float scale = MLA ? 0.07216878364870322f : 0.125f;
    float q[DK / 8];
    if (MLA) {
#pragma unroll
        for (int i = 0; i < DK / 8; ++i) q[i] = bf2f(qm[qrow * 768 + h * 192 + part + 8 * i]);
#pragma unroll
        for (int t = 0; t < 4; ++t) { const float x1 = q[16 + t], x2 = q[20 + t]; const float cs = cosm[qrow * 32 + part + 8 * t], sn = sinm[qrow * 32 + part + 8 * t]; q[16 + t] = x1 * cs - x2 * sn; q[20 + t] = x1 * sn + x2 * cs; }
    } else {
#pragma unroll
        for (int i = 0; i < DK / 8; ++i) q[i] = bf2f(proj[qrow * PROJ_LD + PA_Q + h * 128 + m * 64 + part + 8 * i]);
        const float x1 = q[0], x2 = q[1]; const float cs = cosd[qrow * 8 + part], sn = sind[qrow * 8 + part]; q[0] = x1 * cs - x2 * sn; q[1] = x1 * sn + x2 * cs;
    }
#pragma unroll
    for (int i = 0; i < DK / 8; ++i) q[i] *= scale;
    float o[16]; float mx = -INFINITY, l = 0.f;
#pragma unroll
    for (int i = 0; i < 16; ++i) o[i] = 0.f;
    LAS float* Ks = (LAS float*)c.lds; LAS float* Vs = Ks + 64 * DK;
    for (int kt = 0; kt <= qb; ++kt) {
        __syncthreads();
        for (int e = c.tid; e < 64 * DK; e += 512) { const int j = e / DK, d = e % DK; const size_t krow = rowbase + kt * 64 + j; float v;
            if (MLA) { v = d < 128 ? bf2f(kvm[krow * 1024 + h * 256 + d]) : bf2f(krope[krow * 64 + d - 128]); }
            else { const bf16* kb = proj + krow * PROJ_LD + PA_K + h * 128 + m * 64;
                if (d >= 16) v = bf2f(kb[d]); else { const int i = d & 7; const float x1 = bf2f(kb[i]), x2 = bf2f(kb[i + 8]); const float cs = cosd[krow * 8 + i], sn = sind[krow * 8 + i]; v = d < 8 ? x1 * cs - x2 * sn : x1 * sn + x2 * cs; } }
            Ks[e] = v; }
        for (int e = c.tid; e < 64 * 128; e += 512) { const int j = e >> 7, d = e & 127; const size_t krow = rowbase + kt * 64 + j;
            Vs[e] = MLA ? bf2f(kvm[krow * 1024 + h * 256 + 128 + d]) : bf2f(proj[krow * PROJ_LD + PA_V + h * 128 + d]); }
        __syncthreads();
        const int jmax = (kt == qb) ? r : 63;
        for (int j = 0; j < 64; ++j) {
            float s = 0.f;
#pragma unroll
            for (int i = 0; i < DK / 8; ++i) s += q[i] * Ks[j * DK + part + 8 * i];
            s += __shfl_xor(s, 1); s += __shfl_xor(s, 2); s += __shfl_xor(s, 4);
            if (j <= jmax) {
                if (s > mx) { const float f = __expf(mx - s); l *= f;
#pragma unroll
                    for (int i = 0; i < 16; ++i) o[i] *= f;
                    mx = s; }
                const float pe = __expf(s - mx); l += pe;
#pragma unroll
                for (int i = 0; i < 16; ++i) o[i] += pe * Vs[j * 128 + part * 16 + i];
            }
        }
    }
    const float inv = 1.0f / l;
    if (MLA) { bf16* ob = (bf16*)(p.ws + WS_OBR) + qrow * 2048 + 1024 + h * 128 + part * 16;
#pragma unroll
        for (int i = 0; i < 16; ++i) ob[i] = (bf16)f2bf(o[i] * inv); }
    else { float* ra = (float*)(p.ws + WS_RAWA) + ((size_t)m * MTOK + qrow) * 512 + h * 128 + part * 16;
#pragma unroll
        for (int i = 0; i < 16; ++i) ra[i] = o[i] * inv; }
}
__device__ __forceinline__ void gla_naive_item(PRM p, Ctx& c, int layer, int inst) {
    const bf16* proj = (const bf16*)(p.ws + WS_PROJ); float* rawb = (float*)(p.ws + WS_RAWB);
    const float* w2 = p.gla_w_gate2 + layer * 16 * 256; const float* b2 = p.gla_b_gate + layer * 256;
    const int b = inst >> 2, h = inst & 3; const size_t rowbase = (size_t)b * SEQ;
    LAS float* Qs = (LAS float*)c.lds; LAS float* Ks = Qs + 64 * 64; LAS float* Es = Ks + 64 * 64;
    float S[64];
#pragma unroll
    for (int i = 0; i < 64; ++i) S[i] = 0.f;
    for (int ch = 0; ch < SEQ / 64; ++ch) {
        __syncthreads();
        for (int e = c.tid; e < 64 * 64; e += 512) { const int t = e >> 6, d = e & 63; const bf16* pr = proj + (rowbase + ch * 64 + t) * PROJ_LD;
            Qs[e] = bf2f(pr[PB_Q + h * 64 + d]) * 0.125f; Ks[e] = bf2f(pr[PB_K + h * 64 + d]);
            float a = b2[h * 64 + d];
#pragma unroll
            for (int r = 0; r < 16; ++r) a += bf2f(pr[PB_GLOW + r]) * w2[r * 256 + h * 64 + d];
            Es[e] = __expf(logsigmoid_f(a) * (1.f / 16.f)); }
        __syncthreads();
        if (c.tid < 128) {
            for (int t = 0; t < 64; ++t) { const size_t row = rowbase + ch * 64 + t; const float v = bf2f(proj[row * PROJ_LD + PB_V + h * 128 + c.tid]); float o = 0.f;
#pragma unroll
                for (int d = 0; d < 64; ++d) { S[d] = Es[t * 64 + d] * S[d] + Ks[t * 64 + d] * v; o += Qs[t * 64 + d] * S[d]; }
                rawb[row * 512 + h * 128 + c.tid] = o; }
        }
    }
}
__device__ __forceinline__ void ssd_naive_item(PRM p, Ctx& c, int layer, int b) {
    const bf16* xbc = (const bf16*)(p.ws + WS_XBC); const float* dt = (const float*)(p.ws + WS_DT); float* rawd = (float*)(p.ws + WS_RAWD);
    const int hd = c.wave, g = hd >> 2, lane = c.lane; const size_t rowbase = (size_t)b * SEQ;
    const float a = -__expf(p.ssd_a_log[layer * 8 + hd]), dsk = p.ssd_d[layer * 8 + hd];
    LAS float* Bs = (LAS float*)c.lds; LAS float* Cs = Bs + 32 * 256;
    float hs[128];
#pragma unroll
    for (int i = 0; i < 128; ++i) hs[i] = 0.f;
    for (int ch = 0; ch < SEQ / 32; ++ch) {
        __syncthreads();
        for (int e = c.tid; e < 32 * 256; e += 512) { const int t = e >> 8, n = e & 255; const bf16* xr = xbc + (rowbase + ch * 32 + t) * 1024; Bs[e] = bf2f(xr[512 + n]); Cs[e] = bf2f(xr[768 + n]); }
        __syncthreads();
        for (int t = 0; t < 32; ++t) { const size_t row = rowbase + ch * 32 + t; const float x = bf2f(xbc[row * 1024 + hd * 64 + lane]); const float dtv = dt[row * 8 + hd];
            const float dec = __expf(dtv * a), xdt = x * dtv; float y = 0.f;
#pragma unroll
            for (int n = 0; n < 128; ++n) { hs[n] = hs[n] * dec + xdt * Bs[t * 256 + g * 128 + n]; y += Cs[t * 256 + g * 128 + n] * hs[n]; }
            rawd[row * 512 + hd * 64 + lane] = y + dsk * x; }
    }
}
__device__ __forceinline__ void ph_mix_naive(PRM p, Ctx& c, int layer) {
#ifdef DBG_MIX_FAKE
    { const bf16* proj = (const bf16*)(p.ws + WS_PROJ); float* rawa = (float*)(p.ws + WS_RAWA); float* rawb = (float*)(p.ws + WS_RAWB); float* rawd = (float*)(p.ws + WS_RAWD); bf16* obr = (bf16*)(p.ws + WS_OBR);
      for (size_t i = (size_t)c.bid * 512 + c.tid; i < (size_t)MTOK * 512; i += (size_t)c.G * 512) { const size_t row = i >> 9; const int col = (int)(i & 511);
          const float v = bf2f(proj[row * PROJ_LD + PA_V + col]);
          rawa[i] = v; rawa[(size_t)MTOK * 512 + i] = 0.5f * v; rawb[i] = bf2f(proj[row * PROJ_LD + PB_V + col]); rawd[i] = bf2f(proj[row * PROJ_LD + PD_Z + col]); obr[row * 2048 + 1024 + col] = proj[row * PROJ_LD + PC_Q + (col % 384)]; }
      return; }
#endif
    if (c.bid < 64) gla_naive_item(p, c, layer, c.bid);
    else if (c.bid < 80) ssd_naive_item(p, c, layer, c.bid - 64);
    for (int it = c.bid; it < 6144; it += c.G) {
        const int qb = 31 - it / 192, j = it % 192;
        if (j < 128) attn_naive_item<64, false>(p, c, j, qb); else attn_naive_item<192, true>(p, c, j - 128, qb);
    }
}

__device__ __forceinline__ void ph_post(PRM p, Ctx& c, int layer) {
    const bf16* proj = (const bf16*)(p.ws + WS_PROJ); bf16* obr = (bf16*)(p.ws + WS_OBR);
    const float* rawa = (const float*)(p.ws + WS_RAWA); const float* rawb = (const float*)(p.ws + WS_RAWB); const float* rawd = (const float*)(p.ws + WS_RAWD);
    const int lane = c.lane, gw = c.bid * 8 + c.wave, NGW = c.G * 8;
    const float* lp = p.diff_lambda + layer * 256;
    const float l01 = lp[lane] * lp[64 + lane], l23 = lp[128 + lane] * lp[192 + lane];
    const float lam_init = p.lam_init[layer];
    const float lam = __expf(wave_sum(l01)) - __expf(wave_sum(l23)) + lam_init;
    float sg[8], gg[8], ng[8];
    { const float* s1 = p.diff_subln_g + layer * 128 + 8 * (lane & 15); const float* s2 = p.gla_norm_g + layer * 128 + 8 * (lane & 15); const float* s3 = p.ssd_norm_g + layer * 512 + 8 * lane;
#pragma unroll
      for (int j = 0; j < 8; ++j) { sg[j] = s1[j] * (1.0f - lam_init); gg[j] = s2[j]; ng[j] = s3[j]; } }
    for (int row = gw; row < MTOK; row += NGW) {
        const bf16* pr = proj + (size_t)row * PROJ_LD; bf16* orow = obr + (size_t)row * 2048;
        const size_t ro = (size_t)row * 512 + 8 * lane;
        { const f32x4 a0 = *(const GAS f32x4*)(rawa + ro), a1 = *(const GAS f32x4*)(rawa + ro + 4), b0 = *(const GAS f32x4*)(rawa + (size_t)MTOK * 512 + ro), b1 = *(const GAS f32x4*)(rawa + (size_t)MTOK * 512 + ro + 4);
          float x[8] = {a0.x - lam * b0.x, a0.y - lam * b0.y, a0.z - lam * b0.z, a0.w - lam * b0.w, a1.x - lam * b1.x, a1.y - lam * b1.y, a1.z - lam * b1.z, a1.w - lam * b1.w}; float ss = 0.f;
#pragma unroll
          for (int j = 0; j < 8; ++j) ss += x[j] * x[j];
          const float rs = 1.0f / sqrtf(group_sum16(ss) * (1.f / 128.f) + NORM_EPS);
#pragma unroll
          for (int j = 0; j < 8; ++j) x[j] = x[j] * rs * sg[j];
          *(GAS v4u*)(orow + 8 * lane) = pack8(x); }
        { const f32x4 a0 = *(const GAS f32x4*)(rawb + ro), a1 = *(const GAS f32x4*)(rawb + ro + 4);
          float x[8] = {a0.x, a0.y, a0.z, a0.w, a1.x, a1.y, a1.z, a1.w}; float r[8]; unpack8(*(const GAS v4u*)(pr + PB_R + 8 * lane), r); float ss = 0.f;
#pragma unroll
          for (int j = 0; j < 8; ++j) ss += x[j] * x[j];
          const float rs = 1.0f / sqrtf(group_sum16(ss) * (1.f / 128.f) + NORM_EPS);
#pragma unroll
          for (int j = 0; j < 8; ++j) x[j] = x[j] * rs * gg[j] * (r[j] * pg8::fsigmoid(r[j]));
          *(GAS v4u*)(orow + 512 + 8 * lane) = pack8(x); }
        { const f32x4 a0 = *(const GAS f32x4*)(rawd + ro), a1 = *(const GAS f32x4*)(rawd + ro + 4);
          float x[8] = {a0.x, a0.y, a0.z, a0.w, a1.x, a1.y, a1.z, a1.w}; float z[8]; unpack8(*(const GAS v4u*)(pr + PD_Z + 8 * lane), z); float ss = 0.f;
#pragma unroll
          for (int j = 0; j < 8; ++j) { x[j] *= z[j] * pg8::fsigmoid(z[j]); ss += x[j] * x[j]; }
          const float rs = 1.0f / sqrtf(group_sum32(ss) * (1.f / 256.f) + NORM_EPS);
#pragma unroll
          for (int j = 0; j < 8; ++j) x[j] = x[j] * rs * ng[j];
          *(GAS v4u*)(orow + 1536 + 8 * lane) = pack8(x); }
    }
}


__device__ __forceinline__ bf16x8 frag_row(const LAS unsigned char* base, int RS, int row0, int k0, int lane) {
    return *(const LAS bf16x8*)(base + (row0 + (lane & 31)) * RS + (k0 + 8 * (lane >> 5)) * 2);
}
template <bool PERM> __device__ __forceinline__ bf16x8 frag_tr(const LAS unsigned char* base, int RS, int k0, int n0, int lane) {
    const int hh = lane >> 5, q = (lane & 15) >> 2, pp = lane & 3, blk = (lane >> 4) & 1;
    const int r0 = PERM ? k0 + 4 * hh : k0 + 8 * hh, r1 = PERM ? r0 + 8 : r0 + 4;
    const LAS unsigned char* a = base + (n0 + 16 * blk + 4 * pp) * 2 + q * RS;
    const v4i16_t lo = __builtin_amdgcn_ds_read_tr16_b64_v4i16((LAS v4i16_t*)(a + r0 * RS));
    const v4i16_t hi = __builtin_amdgcn_ds_read_tr16_b64_v4i16((LAS v4i16_t*)(a + r1 * RS));
    return (bf16x8){lo[0], lo[1], lo[2], lo[3], hi[0], hi[1], hi[2], hi[3]};
}
__device__ __forceinline__ bf16x8 frag_acc(const f32x16& x, int s) {
    v4u w; w.x = pg8::cvt_pk_bf16(x[8 * s + 0], x[8 * s + 1]); w.y = pg8::cvt_pk_bf16(x[8 * s + 2], x[8 * s + 3]); w.z = pg8::cvt_pk_bf16(x[8 * s + 4], x[8 * s + 5]); w.w = pg8::cvt_pk_bf16(x[8 * s + 6], x[8 * s + 7]);
    return __builtin_bit_cast(bf16x8, w);
}
#define MFMA32(a, b, c) __builtin_amdgcn_mfma_f32_32x32x16_bf16((a), (b), (c), 0, 0, 0)

constexpr int SSD_RSB = 272, SSD_RSX = 144;
constexpr int SSD_OB = 0, SSD_OC = 34816, SSD_OXT = 69632, SSD_OXD = 88064, SSD_OS = 106496, SSD_OA = 123904, SSD_ODA = 124416, SSD_ODT = 124928;
__device__ __forceinline__ void ssd_unit(PRM p, Ctx& c, int layer, int inst) {
    const bf16* xbc = (const bf16*)(p.ws + WS_XBC); const float* dtg = (const float*)(p.ws + WS_DT); float* rawd = (float*)(p.ws + WS_RAWD);
    int lane_ = (int)xb_lane(); asm volatile("" : "+v"(lane_)); const int lane = lane_, wid = c.wave, tid = wid * 64 + lane, l31 = lane & 31, hh = lane >> 5;
    const int b = inst >> 3, hd = inst & 7, g = hd >> 2; const size_t rowbase = (size_t)b * SEQ;
    const float a = -__expf(p.ssd_a_log[layer * 8 + hd]), dsk = p.ssd_d[layer * 8 + hd];
    LAS unsigned char* L = c.lds;
    LAS float* acum = (LAS float*)(L + SSD_OA); LAS float* dal = (LAS float*)(L + SSD_ODA); LAS float* dtl = (LAS float*)(L + SSD_ODT);
    const int ib = wid >> 1, pb = wid & 1;
    const int spb = wid >> 2, snb = wid & 3;
    f32x16 sacc;
#pragma unroll
    for (int r = 0; r < 16; ++r) sacc[r] = 0.f;
    __syncthreads();
    { unsigned z = 0u; asm volatile("" : "+v"(z)); const v4u zz = {z, z, z, z};
      for (int e = tid; e < 64 * SSD_RSB / 16; e += 512) *(LAS v4u*)(L + SSD_OS + e * 16) = zz; }
    for (int ch = 0; ch < SEQ / 128; ++ch) {
        const size_t row0 = rowbase + ch * 128;
        __syncthreads();
        if (tid < 128) { const float d = dtg[(row0 + tid) * 8 + hd]; dtl[tid] = d; dal[tid] = d * a; }
        __syncthreads();
        if (tid < 128) { float s = 0.f; for (int u = 0; u <= tid; ++u) s += dal[u]; acum[tid] = s; }
        __syncthreads();
        const float alast = acum[127];
#pragma unroll
        for (int i = 0; i < 4; ++i) { const int e = tid + 512 * i, j = e >> 4, ci = e & 15; const bf16* src = xbc + (row0 + j) * 1024 + 512 + g * 128 + ci * 8;
            const v4u vb = *(const GAS v4u*)src, vc = *(const GAS v4u*)(src + 256);
            *(LAS v4u*)(L + SSD_OB + j * SSD_RSB + ci * 16) = vb; *(LAS v4u*)(L + SSD_OC + j * SSD_RSB + ci * 16) = vc; }
#pragma unroll
        for (int i = 0; i < 2; ++i) { const int e = tid + 512 * i, j = e >> 3, ci = e & 7; const v4u vx = *(const GAS v4u*)(xbc + (row0 + j) * 1024 + hd * 64 + ci * 8);
            const float d = dtl[j], dd = d * __expf(alast - acum[j]);
            v4u o1, o2;
#define SSD_SC(F) { const float lo = pg8::bfl(vx.F), hi = pg8::bfh(vx.F); o1.F = pg8::cvt_pk_bf16(lo * d, hi * d); o2.F = pg8::cvt_pk_bf16(lo * dd, hi * dd); }
            SSD_SC(x) SSD_SC(y) SSD_SC(z) SSD_SC(w)
#undef SSD_SC
            *(LAS v4u*)(L + SSD_OXT + j * SSD_RSX + ci * 16) = o1; *(LAS v4u*)(L + SSD_OXD + j * SSD_RSX + ci * 16) = o2; }
        __syncthreads();
        f32x16 y;
#pragma unroll
        for (int r = 0; r < 16; ++r) y[r] = 0.f;
        const float ai = acum[ib * 32 + l31];
        for (int jb = 0; jb <= ib; ++jb) {
            f32x16 t;
#pragma unroll
            for (int r = 0; r < 16; ++r) t[r] = 0.f;
#pragma unroll
            for (int ks = 0; ks < 8; ++ks) t = MFMA32(frag_row(L + SSD_OB, SSD_RSB, jb * 32, ks * 16, lane), frag_row(L + SSD_OC, SSD_RSB, ib * 32, ks * 16, lane), t);
            const int ii = ib * 32 + l31;
#pragma unroll
            for (int r = 0; r < 16; ++r) { const int jj = jb * 32 + crow(r, hh); const float w = __expf(ai - acum[jj]); t[r] = (jj <= ii) ? t[r] * w : 0.f; }
#pragma unroll
            for (int s = 0; s < 2; ++s) y = MFMA32(frag_acc(t, s), frag_tr<true>(L + SSD_OXT, SSD_RSX, jb * 32 + 16 * s, pb * 32, lane), y);
        }
        { f32x16 yo;
#pragma unroll
          for (int r = 0; r < 16; ++r) yo[r] = 0.f;
#pragma unroll
          for (int ks = 0; ks < 8; ++ks) yo = MFMA32(frag_row(L + SSD_OC, SSD_RSB, ib * 32, ks * 16, lane), frag_row(L + SSD_OS, SSD_RSB, pb * 32, ks * 16, lane), yo);
#pragma unroll
          for (int r = 0; r < 16; ++r) { const int i = ib * 32 + crow(r, hh); y[r] += yo[r] * __expf(acum[i]); } }
        { float* yo = rawd + (row0 + ib * 32) * 512 + hd * 64 + pb * 32 + l31; const bf16* xr = xbc + (row0 + ib * 32) * 1024 + hd * 64 + pb * 32 + l31;
#pragma unroll
          for (int r = 0; r < 16; ++r) { const int i = crow(r, hh); yo[(size_t)i * 512] = y[r] + dsk * bf2f(xr[(size_t)i * 1024]); } }
        { const float dec = __expf(alast);
#pragma unroll
          for (int r = 0; r < 16; ++r) sacc[r] *= dec;
#pragma unroll
          for (int ks = 0; ks < 8; ++ks) sacc = MFMA32(frag_tr<false>(L + SSD_OXD, SSD_RSX, ks * 16, spb * 32, lane), frag_tr<false>(L + SSD_OB, SSD_RSB, ks * 16, snb * 32, lane), sacc); }
        __syncthreads();
        { LAS bf16* sl = (LAS bf16*)(L + SSD_OS);
#pragma unroll
          for (int r = 0; r < 16; ++r) sl[(spb * 32 + crow(r, hh)) * (SSD_RSB / 2) + snb * 32 + l31] = (bf16)f2bf(sacc[r]); }
    }
}

constexpr int GLA_RSK = 144, GLA_RSV = 272;
constexpr int GLA_OQT = 0, GLA_OKT = 9216, GLA_OKD = 18432, GLA_OV = 27648, GLA_OST = 45056, GLA_OG = 63488, GLA_OP = 79872, GLA_OGL = 81920, GLA_OEB = 86016;
__device__ __forceinline__ void gla_pre_unit(PRM p, Ctx& c, int layer, int u) {
    const bf16* proj = (const bf16*)(p.ws + WS_PROJ);
    bf16* qtg = (bf16*)(p.ws + WS_GQT); bf16* ktg = (bf16*)(p.ws + WS_GKT); bf16* kdg = (bf16*)(p.ws + WS_GKD); float* ebl = (float*)(p.ws + WS_GEB);
    const float* w2 = p.gla_w_gate2 + layer * 16 * 256; const float* b2 = p.gla_b_gate + layer * 256;
    const int tid = c.tid, ch = u & 31, h = (u >> 5) & 3, b = u >> 7; const size_t row0 = (size_t)b * SEQ + ch * 64;
    LAS unsigned char* L = c.lds; LAS float* gl = (LAS float*)(L + GLA_OG); LAS float* part = (LAS float*)(L + GLA_OP); LAS float* glow = (LAS float*)(L + GLA_OGL);
    const int dcol = tid & 63, seg = tid >> 6;
    float w2c[16]; const float b2c = b2[h * 64 + dcol];
#pragma unroll
    for (int r = 0; r < 16; ++r) w2c[r] = w2[r * 256 + h * 64 + dcol];
    __syncthreads();
    { const int t = tid >> 3, r2 = (tid & 7) * 2; const unsigned w = *(const GAS unsigned*)(proj + (row0 + t) * PROJ_LD + PB_GLOW + r2); glow[t * 16 + r2] = pg8::bfl(w); glow[t * 16 + r2 + 1] = pg8::bfh(w); }
    __syncthreads();
    float gv[8]; float ssum = 0.f;
#pragma unroll
    for (int k = 0; k < 8; ++k) { const int t = seg * 8 + k; float a = b2c;
#pragma unroll
        for (int r = 0; r < 16; ++r) a += glow[t * 16 + r] * w2c[r];
        gv[k] = logsigmoid_f(a) * (1.f / 16.f); ssum += gv[k]; }
    part[seg * 64 + dcol] = ssum;
    __syncthreads();
    { float pre = 0.f;
#pragma unroll
      for (int s2 = 0; s2 < 8; ++s2) if (s2 < seg) pre += part[s2 * 64 + dcol];
#pragma unroll
      for (int k = 0; k < 8; ++k) { pre += gv[k]; gl[(seg * 8 + k) * 64 + dcol] = pre; } }
    __syncthreads();
    { const int t = tid >> 3, ci = tid & 7; const bf16* pr = proj + (row0 + t) * PROJ_LD;
      const v4u vq = *(const GAS v4u*)(pr + PB_Q + h * 64 + ci * 8), vk = *(const GAS v4u*)(pr + PB_K + h * 64 + ci * 8);
      v4u oq, ok, od;
#define GLA_SC(F, D0) { const float b0 = gl[t * 64 + ci * 8 + D0], b1 = gl[t * 64 + ci * 8 + D0 + 1], l0 = gl[63 * 64 + ci * 8 + D0], l1 = gl[63 * 64 + ci * 8 + D0 + 1]; \
        const float e0 = __expf(b0), e1 = __expf(b1); const float q0 = pg8::bfl(vq.F) * 0.125f, q1 = pg8::bfh(vq.F) * 0.125f, k0 = pg8::bfl(vk.F), k1 = pg8::bfh(vk.F); \
        oq.F = pg8::cvt_pk_bf16(q0 * e0, q1 * e1); ok.F = pg8::cvt_pk_bf16(k0 * __expf(-b0), k1 * __expf(-b1)); od.F = pg8::cvt_pk_bf16(k0 * __expf(l0 - b0), k1 * __expf(l1 - b1)); }
      GLA_SC(x, 0) GLA_SC(y, 2) GLA_SC(z, 4) GLA_SC(w, 6)
#undef GLA_SC
      const size_t go = (row0 + t) * 256 + h * 64 + ci * 8;
      *(GAS v4u*)(qtg + go) = oq; *(GAS v4u*)(ktg + go) = ok; *(GAS v4u*)(kdg + go) = od;
      if (t == 63) { float* eo = ebl + ((size_t)b * 32 + ch) * 256 + h * 64 + ci * 8;
#pragma unroll
          for (int j = 0; j < 8; ++j) eo[j] = __expf(gl[63 * 64 + ci * 8 + j]); } }
}
__device__ __forceinline__ void gla_unit(PRM p, Ctx& c, int layer, int inst) {
    const bf16* proj = (const bf16*)(p.ws + WS_PROJ); float* rawb = (float*)(p.ws + WS_RAWB);
    const bf16* qtg = (const bf16*)(p.ws + WS_GQT); const bf16* ktg = (const bf16*)(p.ws + WS_GKT); const bf16* kdg = (const bf16*)(p.ws + WS_GKD); const float* ebl = (const float*)(p.ws + WS_GEB);
    int lane_ = (int)xb_lane(); asm volatile("" : "+v"(lane_)); const int lane = lane_, wid = c.wave, tid = wid * 64 + lane, l31 = lane & 31, hh = lane >> 5;
    const int b = inst >> 2, h = inst & 3; const size_t rowbase = (size_t)b * SEQ;
    LAS unsigned char* L = c.lds; LAS float* ebs = (LAS float*)(L + GLA_OEB);
    const int ib = wid >> 2, eb = wid & 3;
    f32x16 sacc;
#pragma unroll
    for (int r = 0; r < 16; ++r) sacc[r] = 0.f;
    __syncthreads();
    { unsigned z = 0u; asm volatile("" : "+v"(z)); const v4u zz = {z, z, z, z};
      for (int e = tid; e < 128 * GLA_RSK / 16; e += 512) *(LAS v4u*)(L + GLA_OST + e * 16) = zz; }
    for (int ch = 0; ch < SEQ / 64; ++ch) {
        const size_t row0 = rowbase + ch * 64;
        __syncthreads();
        { const int t = tid >> 3, ci = tid & 7; const size_t go = (row0 + t) * 256 + h * 64 + ci * 8;
          *(LAS v4u*)(L + GLA_OQT + t * GLA_RSK + ci * 16) = *(const GAS v4u*)(qtg + go); *(LAS v4u*)(L + GLA_OKT + t * GLA_RSK + ci * 16) = *(const GAS v4u*)(ktg + go); *(LAS v4u*)(L + GLA_OKD + t * GLA_RSK + ci * 16) = *(const GAS v4u*)(kdg + go); }
#pragma unroll
        for (int i = 0; i < 2; ++i) { const int e = tid + 512 * i, t = e >> 4, ci = e & 15; *(LAS v4u*)(L + GLA_OV + t * GLA_RSV + ci * 16) = *(const GAS v4u*)(proj + (row0 + t) * PROJ_LD + PB_V + h * 128 + ci * 8); }
        if (tid < 64) ebs[tid] = ebl[((size_t)b * 32 + ch) * 256 + h * 64 + tid];
        __syncthreads();
        f32x16 o;
#pragma unroll
        for (int r = 0; r < 16; ++r) o[r] = 0.f;
        for (int jb = 0; jb <= ib; ++jb) {
            f32x16 t;
#pragma unroll
            for (int r = 0; r < 16; ++r) t[r] = 0.f;
#pragma unroll
            for (int ks = 0; ks < 4; ++ks) t = MFMA32(frag_row(L + GLA_OKT, GLA_RSK, jb * 32, ks * 16, lane), frag_row(L + GLA_OQT, GLA_RSK, ib * 32, ks * 16, lane), t);
            if (jb == ib) {
#pragma unroll
                for (int r = 0; r < 16; ++r) if (crow(r, hh) > l31) t[r] = 0.f; }
#pragma unroll
            for (int s = 0; s < 2; ++s) o = MFMA32(frag_acc(t, s), frag_tr<true>(L + GLA_OV, GLA_RSV, jb * 32 + 16 * s, eb * 32, lane), o);
        }
#pragma unroll
        for (int ks = 0; ks < 4; ++ks) o = MFMA32(frag_row(L + GLA_OQT, GLA_RSK, ib * 32, ks * 16, lane), frag_row(L + GLA_OST, GLA_RSK, eb * 32, ks * 16, lane), o);
        { float* ob = rawb + (row0 + ib * 32) * 512 + h * 128 + eb * 32 + l31;
#pragma unroll
          for (int r = 0; r < 16; ++r) ob[(size_t)crow(r, hh) * 512] = o[r]; }
#pragma unroll
        for (int r = 0; r < 16; ++r) sacc[r] *= ebs[ib * 32 + crow(r, hh)];
#pragma unroll
        for (int ks = 0; ks < 4; ++ks) sacc = MFMA32(frag_tr<false>(L + GLA_OKD, GLA_RSK, ks * 16, ib * 32, lane), frag_tr<false>(L + GLA_OV, GLA_RSV, ks * 16, eb * 32, lane), sacc);
        __syncthreads();
        { LAS bf16* st = (LAS bf16*)(L + GLA_OST);
#pragma unroll
          for (int r = 0; r < 16; ++r) st[(eb * 32 + l31) * (GLA_RSK / 2) + ib * 32 + crow(r, hh)] = (bf16)f2bf(sacc[r]); }
    }
}

__device__ __forceinline__ float swap32_max(float v) { auto rr = __builtin_amdgcn_permlane32_swap(__float_as_uint(v), __float_as_uint(v), false, false); return fmaxf(__uint_as_float(rr[0]), __uint_as_float(rr[1])); }
__device__ __forceinline__ float swap32_sum(float v) { auto rr = __builtin_amdgcn_permlane32_swap(__float_as_uint(v), __float_as_uint(v), false, false); return __uint_as_float(rr[0]) + __uint_as_float(rr[1]); }
constexpr int ATT_VRS = 320;
template <int DK, bool MLA>
__device__ __forceinline__ void attn_unit(PRM p, Ctx& c, int inst, int qb) {
    constexpr int RSK = DK * 2 + 16, CPK = DK / 8, NKC = (64 * CPK) / 512;
    constexpr int KBUF = 64 * RSK, VBUF = 64 * ATT_VRS;
    const bf16* proj = (const bf16*)(p.ws + WS_PROJ); const bf16* qm = (const bf16*)(p.ws + WS_QM); const bf16* kvm = (const bf16*)(p.ws + WS_KVM); const bf16* krope = (const bf16*)(p.ws + WS_KROPE);
    int lane_ = (int)xb_lane(); asm volatile("" : "+v"(lane_)); int tid_ = c.wave * 64 + lane_;
    const int lane = lane_, tid = tid_, wid = c.wave, q32 = lane & 31, hh = lane >> 5;
    int b, h, m = 0; if (MLA) { b = inst >> 2; h = inst & 3; } else { m = inst & 1; h = (inst >> 1) & 3; b = inst >> 3; }
    const size_t rowbase = (size_t)b * SEQ; const int q0 = qb * 256, qw = q0 + wid * 32;
    const float C2 = (MLA ? 0.07216878364870322f : 0.125f) * 1.4426950408889634f;
    LAS unsigned char* Kb = c.lds; LAS unsigned char* Vb = c.lds + 2 * KBUF; LAS float* wsf = (LAS float*)(c.lds + 2 * KBUF + 2 * VBUF) + wid * 64;
    bf16x8 qf[DK / 16];
    { const size_t qrow = rowbase + qw + q32;
      if (MLA) { const bf16* qp = qm + qrow * 768 + h * 192;
#pragma unroll
          for (int ks = 0; ks < DK / 16; ++ks) qf[ks] = *(const GAS bf16x8*)(qp + ks * 16 + hh * 8);
          const float* cosm = (const float*)(p.ws + WS_ROPE) + (size_t)MTOK * 16 + qrow * 32; const float* sinm = cosm + (size_t)MTOK * 32;
#pragma unroll
          for (int t = 0; t < 2; ++t) {
#pragma unroll
              for (int j = 0; j < 8; ++j) { const int i = 16 * t + 8 * hh + j; const float cs = cosm[i], sn = sinm[i];
                  const float x1 = bf2f((bf16)qf[8 + t][j]), x2 = bf2f((bf16)qf[10 + t][j]);
                  qf[8 + t][j] = (short)f2bf(x1 * cs - x2 * sn); qf[10 + t][j] = (short)f2bf(x1 * sn + x2 * cs); } }
      } else { const bf16* qp = proj + qrow * PROJ_LD + PA_Q + h * 128 + m * 64;
#pragma unroll
          for (int ks = 0; ks < DK / 16; ++ks) qf[ks] = *(const GAS bf16x8*)(qp + ks * 16 + hh * 8); } }
    v4u kreg[NKC], vreg[2];
    unsigned kgo[NKC], klo[NKC], vgo[2], vlo[2];
    const char* kg0p; const char* kg1p; const char* vgp; unsigned kpitch0, kpitch1, vpitch;
    if (MLA) { kg0p = (const char*)(kvm + rowbase * 1024 + h * 256); kpitch0 = 2048; kg1p = (const char*)(krope + rowbase * 64); kpitch1 = 128; vgp = (const char*)(kvm + rowbase * 1024 + h * 256 + 128); vpitch = 2048; }
    else { kg0p = (const char*)(proj + rowbase * PROJ_LD + PA_K + h * 128 + m * 64); kpitch0 = PROJ_LD * 2; kg1p = kg0p; kpitch1 = kpitch0; vgp = (const char*)(proj + rowbase * PROJ_LD + PA_V + h * 128); vpitch = PROJ_LD * 2; }
    if (MLA) {
#pragma unroll
        for (int i = 0; i < 2; ++i) { const int e = tid + 512 * i, j = e >> 4, ci = e & 15; kgo[i] = (unsigned)j * kpitch0 + ci * 16; klo[i] = j * RSK + ci * 16; }
        { const int j = tid >> 3, ci = tid & 7; kgo[NKC - 1] = (unsigned)j * kpitch1 + ci * 16; klo[NKC - 1] = j * RSK + 256 + ci * 16; }
    } else { const int j = tid >> 3, ci = tid & 7; kgo[0] = (unsigned)j * kpitch0 + ci * 16; klo[0] = j * RSK + ci * 16; }
#pragma unroll
    for (int i = 0; i < 2; ++i) { const int e = tid + 512 * i, j = e >> 4, ci = e & 15; vgo[i] = (unsigned)j * vpitch + ci * 16; vlo[i] = j * ATT_VRS + ci * 16; }
    auto gload = [&](int kt) {
        const char* k0 = kg0p + (size_t)kt * 64 * kpitch0; const char* k1 = kg1p + (size_t)kt * 64 * kpitch1; const char* v0 = vgp + (size_t)kt * 64 * vpitch;
#pragma unroll
        for (int i = 0; i < NKC; ++i) kreg[i] = *(const GAS v4u*)(((MLA && i == NKC - 1) ? k1 : k0) + kgo[i]);
#pragma unroll
        for (int i = 0; i < 2; ++i) vreg[i] = *(const GAS v4u*)(v0 + vgo[i]); };
    auto lstore = [&](int buf) {
#pragma unroll
        for (int i = 0; i < NKC; ++i) *(LAS v4u*)(Kb + buf * KBUF + klo[i]) = kreg[i];
#pragma unroll
        for (int i = 0; i < 2; ++i) *(LAS v4u*)(Vb + buf * VBUF + vlo[i]) = vreg[i]; };
    const int NT = 4 * qb + 4;
    const int ktmax = 4 * qb + (wid >> 1);
    f32x16 o[4];
#pragma unroll
    for (int d = 0; d < 4; ++d)
#pragma unroll
        for (int r = 0; r < 16; ++r) o[d][r] = 0.f;
    float mrun = -INFINITY, lrun = 0.f;
    __syncthreads();
    gload(0); lstore(0);
    __syncthreads();
    for (int kt = 0; kt < NT; ++kt) {
        const int buf = kt & 1;
        if (!MLA && kt + 1 < NT) gload(kt + 1);
        if (kt <= ktmax) {
            f32x16 p0, p1;
#pragma unroll
            for (int r = 0; r < 16; ++r) { p0[r] = 0.f; p1[r] = 0.f; }
            const LAS unsigned char* kbase = Kb + buf * KBUF + q32 * RSK + hh * 16;
#pragma unroll
            for (int ks = 0; ks < DK / 16; ++ks) {
                const bf16x8 k0 = *(const LAS bf16x8*)(kbase + ks * 32), k1 = *(const LAS bf16x8*)(kbase + 32 * RSK + ks * 32);
                p0 = __builtin_amdgcn_mfma_f32_32x32x16_bf16(k0, qf[ks], p0, 0, 0, 0);
                p1 = __builtin_amdgcn_mfma_f32_32x32x16_bf16(k1, qf[ks], p1, 0, 0, 0); }
            const bool band = kt >= 4 * qb; const int qg = qw + q32, kg0 = kt * 64;
            float rm = -INFINITY;
#pragma unroll
            for (int r = 0; r < 16; ++r) { float a = p0[r] * C2, bb = p1[r] * C2;
                if (band) { const int kk = kg0 + crow(r, hh); if (kk > qg) a = -INFINITY; if (kk + 32 > qg) bb = -INFINITY; }
                p0[r] = a; p1[r] = bb; rm = fmaxf(rm, fmaxf(a, bb)); }
            rm = swap32_max(rm);
            if (__any(rm > mrun)) {
                const float mnew = fmaxf(mrun, rm); const float alpha = __builtin_amdgcn_exp2f(mrun - mnew);
                mrun = mnew; lrun *= alpha;
                if (hh == 0) wsf[q32] = alpha;
                asm volatile("s_waitcnt lgkmcnt(0)" ::: "memory");
                float al[16];
#pragma unroll
                for (int r = 0; r < 16; ++r) al[r] = wsf[crow(r, hh)];
#pragma unroll
                for (int d = 0; d < 4; ++d)
#pragma unroll
                    for (int r = 0; r < 16; ++r) o[d][r] *= al[r];
            }
            float ls = 0.f;
#pragma unroll
            for (int r = 0; r < 16; ++r) { p0[r] = __builtin_amdgcn_exp2f(p0[r] - mrun); p1[r] = __builtin_amdgcn_exp2f(p1[r] - mrun); ls += p0[r] + p1[r]; }
            lrun += ls;
            bf16x8 pf[4];
#pragma unroll
            for (int s = 0; s < 2; ++s) {
                v4u w0, w1;
                w0.x = pg8::cvt_pk_bf16(p0[8 * s + 0], p0[8 * s + 1]); w0.y = pg8::cvt_pk_bf16(p0[8 * s + 2], p0[8 * s + 3]); w0.z = pg8::cvt_pk_bf16(p0[8 * s + 4], p0[8 * s + 5]); w0.w = pg8::cvt_pk_bf16(p0[8 * s + 6], p0[8 * s + 7]);
                w1.x = pg8::cvt_pk_bf16(p1[8 * s + 0], p1[8 * s + 1]); w1.y = pg8::cvt_pk_bf16(p1[8 * s + 2], p1[8 * s + 3]); w1.z = pg8::cvt_pk_bf16(p1[8 * s + 4], p1[8 * s + 5]); w1.w = pg8::cvt_pk_bf16(p1[8 * s + 6], p1[8 * s + 7]);
                pf[s] = __builtin_bit_cast(bf16x8, w0); pf[2 + s] = __builtin_bit_cast(bf16x8, w1); }
            __builtin_amdgcn_sched_barrier(0);
            if (MLA && kt + 1 < NT) gload(kt + 1);
            __builtin_amdgcn_sched_barrier(0);
            const LAS unsigned char* vbase = Vb + buf * VBUF + (4 * hh + ((lane & 15) >> 2)) * ATT_VRS + (16 * ((lane >> 4) & 1) + 4 * (lane & 3)) * 2;
#pragma unroll
            for (int ks4 = 0; ks4 < 4; ++ks4) {
#pragma unroll
                for (int d0 = 0; d0 < 4; ++d0) {
                    const LAS unsigned char* vp = vbase + (16 * ks4) * ATT_VRS + d0 * 64;
                    const v4i16_t lo = __builtin_amdgcn_ds_read_tr16_b64_v4i16((LAS v4i16_t*)vp);
                    const v4i16_t hi = __builtin_amdgcn_ds_read_tr16_b64_v4i16((LAS v4i16_t*)(vp + 8 * ATT_VRS));
                    const bf16x8 vf = (bf16x8){lo[0], lo[1], lo[2], lo[3], hi[0], hi[1], hi[2], hi[3]};
                    o[d0] = __builtin_amdgcn_mfma_f32_32x32x16_bf16(pf[ks4], vf, o[d0], 0, 0, 0); }
                __builtin_amdgcn_sched_barrier(0); }
        } else if (MLA && kt + 1 < NT) gload(kt + 1);
        if (kt + 1 < NT) lstore(buf ^ 1);
        __syncthreads();
    }
    lrun = swap32_sum(lrun);
    int hh2 = hh; asm volatile("" : "+v"(hh2));
    if (hh == 0) wsf[q32] = 1.0f / lrun;
    asm volatile("s_waitcnt lgkmcnt(0)" ::: "memory");
    float il[16];
#pragma unroll
    for (int r = 0; r < 16; ++r) il[r] = wsf[crow(r, hh2)];
    if (MLA) { bf16* ob = (bf16*)(p.ws + WS_OBR) + (rowbase + qw) * 2048 + 1024 + h * 128 + q32;
#pragma unroll
        for (int r = 0; r < 16; ++r)
#pragma unroll
            for (int d = 0; d < 4; ++d) ob[crow(r, hh2) * 2048 + d * 32] = (bf16)f2bf(o[d][r] * il[r]); }
    else { float* ra = (float*)(p.ws + WS_RAWA) + ((size_t)m * MTOK + rowbase + qw) * 512 + h * 128 + q32;
#pragma unroll
        for (int r = 0; r < 16; ++r)
#pragma unroll
            for (int d = 0; d < 4; ++d) ra[crow(r, hh2) * 512 + d * 32] = o[d][r] * il[r]; }
}

constexpr int CW_Q = 8192;
__device__ __forceinline__ void ph_mix(PRM p, Ctx& c, int layer, int rep = 0) {
    unsigned* ctr = (unsigned*)(p.ws + WS_CTL) + CW_Q + 64 * layer + 1024 * rep;
    volatile LAS int* slot = (volatile LAS int*)(c.lds + 131072 + 64);
    for (;;) {
        __syncthreads();
        if (xb_thread0(c.wave)) *slot = (int)__hip_atomic_fetch_add(ctr, 1u, __ATOMIC_RELAXED, __HIP_MEMORY_SCOPE_AGENT);
        __syncthreads();
        const int id = *slot;
        if (id >= 192 + 1536) break;
        if (id < 64) { gla_unit(p, c, layer, id); continue; }
        if (id < 192) { ssd_unit(p, c, layer, id - 64); continue; }
        const int ia = id - 192, qb = 7 - ia / 192, j = ia % 192;
        if (j < 64) attn_unit<192, true>(p, c, j, qb); else attn_unit<64, false>(p, c, j - 64, qb);
    }
}

__device__ __forceinline__ void ph_gu(PRM p, Ctx& c, int f) {
    pg8::Gemm g{(const bf16*)(p.ws + WS_HB), (const bf16*)(p.ws + (f ? WS_WGU1 : WS_WGU0)), MTOK, 2 * DFF, DM, DM, DM, 0, 0};
    pg8::StaticOrder S; S.init(MTOK, 2 * DFF, c.G, c.bid);
    pg8::EpiSwiglu E{(bf16*)(p.ws + WS_ACT), DFF, nullptr};
    pg8::gemm_phase<pg8::EpiSwiglu, pg8::StaticOrder, true, true>(c.lds, g, S, E, c.tid);
}
__device__ __forceinline__ void ph_down(PRM p, Ctx& c, int layer, int f, int rep = 0) {
#ifdef DBG_GU_CHECK
    { pg8::Gemm g{(const bf16*)(p.ws + WS_HB), (const bf16*)(p.ws + (f ? WS_WGU1 : WS_WGU0)), MTOK, 2 * DFF, DM, DM, DM, 0, 0};
      pg8::StaticOrder S; S.init(MTOK, 2 * DFF, c.G, c.bid);
      pg8::EpiSwiglu E{(bf16*)(p.ws + WS_ACT), DFF, (float*)(p.ws + WS_ACT)};
      pg8::gemm_phase<pg8::EpiSwiglu, pg8::StaticOrder, true, true>(c.lds, g, S, E, c.tid); }
#endif
    pg8::Gemm g{(const bf16*)(p.ws + WS_ACT), (const bf16*)(p.ws + (f ? WS_WD1 : WS_WD0)), MTOK, DM, DFF, DFF, DFF, 0, 0};
    pg8::StaticOrder S; S.init(MTOK, DM, c.G, c.bid);
    pg8::EpiResidual E{(layer == 0 && f == 0) ? p.x : p.out, rep ? (float*)(p.ws + WS_DUMMY) : p.out, DM, ALPHA, 0.5f};
    pg8::gemm_phase<pg8::EpiResidual, pg8::StaticOrder, true, true>(c.lds, g, S, E, c.tid);
}
__device__ __forceinline__ void ph_win(PRM p, Ctx& c, int layer) {
#ifdef DBG_WIN_FAKE
    { const bf16* hb = (const bf16*)(p.ws + WS_HB); bf16* proj = (bf16*)(p.ws + WS_PROJ); bf16* gates = (bf16*)(p.ws + WS_GATES);
      for (size_t i = (size_t)c.bid * 512 + c.tid; i < (size_t)MTOK * PROJ_LD; i += (size_t)c.G * 512) { const size_t row = i / PROJ_LD; const int col = (int)(i % PROJ_LD); proj[i] = (bf16)f2bf(0.5f * bf2f(hb[row * DM + (col & 2047)])); }
      for (size_t i = (size_t)c.bid * 512 + c.tid; i < (size_t)MTOK * GATE_LD; i += (size_t)c.G * 512) { const size_t row = i >> 13; const int col = (int)(i & 8191); gates[i] = (bf16)f2bf(pg8::fsigmoid(bf2f(hb[row * DM + (col & 2047)]))); }
      return; }
#endif
    pg8::Gemm g{(const bf16*)(p.ws + WS_HB), (const bf16*)(p.ws + WS_WIN), MTOK, NWIN, DM, DM, DM, 0, 0};
    pg8::StaticOrder S; S.init(MTOK, NWIN, c.G, c.bid);
    pg8::EpiWin E{(bf16*)(p.ws + WS_PROJ), PROJ_LD, NPT, (bf16*)(p.ws + WS_GATES), GATE_LD, p.b_gate + (size_t)layer * GATE_LD, nullptr};
    pg8::gemm_phase<pg8::EpiWin, pg8::StaticOrder, true, true>(c.lds, g, S, E, c.tid);
}
__device__ __forceinline__ void ph_up(PRM p, Ctx& c) {
#ifdef DBG_WIN_CHECK
    { pg8::Gemm g{(const bf16*)(p.ws + WS_HB), (const bf16*)(p.ws + WS_WIN), MTOK, NWIN, DM, DM, DM, 0, 0};
      pg8::StaticOrder S; S.init(MTOK, NWIN, c.G, c.bid);
      pg8::EpiWin E{(bf16*)(p.ws + WS_PROJ), PROJ_LD, NPT, (bf16*)(p.ws + WS_GATES), GATE_LD, p.b_gate, p.out};
      pg8::gemm_phase<pg8::EpiWin, pg8::StaticOrder, true, true>(c.lds, g, S, E, c.tid); return; }
#endif
    { pg8::Gemm g{(const bf16*)(p.ws + WS_CQN), (const bf16*)(p.ws + WS_WUQ), MTOK, 768, 384, 384, 384, 0, 0};
      pg8::StaticOrder S; S.init(MTOK, 768, c.G, c.bid);
      pg8::EpiBf16 E{(bf16*)(p.ws + WS_QM), 768};
      pg8::gemm_phase<pg8::EpiBf16, pg8::StaticOrder, true, true>(c.lds, g, S, E, c.tid); }
    { pg8::Gemm g{(const bf16*)(p.ws + WS_CKVN), (const bf16*)(p.ws + WS_WUKV), MTOK, 1024, 256, 256, 256, 0, 0};
      pg8::StaticOrder S; S.init(MTOK, 1024, c.G, c.bid);
      pg8::EpiBf16 E{(bf16*)(p.ws + WS_KVM), 1024};
      pg8::gemm_phase<pg8::EpiBf16, pg8::StaticOrder, true, true>(c.lds, g, S, E, c.tid); }
}
__device__ __forceinline__ void ph_merge(PRM p, Ctx& c) {
#ifdef DBG_MERGE_FAKE
    { const bf16* obr = (const bf16*)(p.ws + WS_OBR); const bf16* gates = (const bf16*)(p.ws + WS_GATES); bf16* merged = (bf16*)(p.ws + WS_MERGED);
      for (size_t i = (size_t)c.bid * 512 + c.tid; i < (size_t)MTOK * DM; i += (size_t)c.G * 512) { const size_t row = i >> 11; const int col = (int)(i & 2047);
          merged[i] = (bf16)f2bf(bf2f(gates[row * GATE_LD + col]) * bf2f(obr[i]) + bf2f(gates[row * GATE_LD + 6144 + col])); }
      return; }
#endif
    pg8::Gemm g{(const bf16*)(p.ws + WS_OBR), (const bf16*)(p.ws + WS_WB), MTOK, DM, 512, DM, 512, (size_t)512 * 2, (size_t)DM * 512 * 2};
    pg8::StaticOrder S; S.init(MTOK, DM, c.G, c.bid, 4);
    pg8::EpiMerge E{(bf16*)(p.ws + WS_MERGED), DM, (const bf16*)(p.ws + WS_GATES), GATE_LD};
    pg8::gemm_phase<pg8::EpiMerge, pg8::StaticOrder, true, true>(c.lds, g, S, E, c.tid);
}
__device__ __forceinline__ void ph_wout(PRM p, Ctx& c) {
    pg8::Gemm g{(const bf16*)(p.ws + WS_MERGED), (const bf16*)(p.ws + WS_WO), MTOK, DM, DM, DM, DM, 0, 0};
    pg8::StaticOrder S; S.init(MTOK, DM, c.G, c.bid);
    pg8::EpiResidual E{p.out, p.out, DM, ALPHA, 1.0f};
    pg8::gemm_phase<pg8::EpiResidual, pg8::StaticOrder, true, true>(c.lds, g, S, E, c.tid);
}

enum { PH_CONVERT = 0, PH_GU, PH_DOWN, PH_LN, PH_WIN, PH_PREP, PH_UP, PH_MIX, PH_POST, PH_MERGE, PH_WOUT, PH_COUNT };
template <int PH> __device__ __forceinline__ void run_phase(PRM p, Ctx& c0, int layer, int sub, int rep = 0) {
    Ctx c = c0; { int l = (int)xb_lane(); asm volatile("" : "+v"(l)); c.lane = l; c.tid = c.wave * 64 + l; }
    if constexpr (PH == PH_CONVERT) ph_convert(p, c, layer);
    if constexpr (PH == PH_GU) ph_gu(p, c, sub >> 1);
    if constexpr (PH == PH_DOWN) ph_down(p, c, layer, sub >> 1, rep);
    if constexpr (PH == PH_LN) ph_ln(p, c, layer, sub, rep);
    if constexpr (PH == PH_WIN) ph_win(p, c, layer);
    if constexpr (PH == PH_PREP) { ph_prep(p, c, layer, rep); for (int u = c.bid; u < BATCH * 4 * (SEQ / 64); u += c.G) gla_pre_unit(p, c, layer, u); }
    if constexpr (PH == PH_UP) ph_up(p, c);
    if constexpr (PH == PH_MIX) ph_mix(p, c, layer, rep);
    if constexpr (PH == PH_POST) ph_post(p, c, layer);
    if constexpr (PH == PH_MERGE) ph_merge(p, c);
    if constexpr (PH == PH_WOUT) ph_wout(p, c);
}
__device__ __forceinline__ Ctx make_ctx(unsigned char* lds) {
    Ctx c; c.lds = (LAS unsigned char*)lds; c.tid = threadIdx.x; c.lane = c.tid & 63; c.wave = __builtin_amdgcn_readfirstlane((int)threadIdx.x >> 6); c.G = gridDim.x; c.bid = blockIdx.x; return c;
}
typedef const __attribute__((address_space(4))) Params* PRMP;
__device__ __forceinline__ PRMP kparams() { PRMP kp = (PRMP)__builtin_amdgcn_kernarg_segment_ptr(); asm volatile("" : "+s"(kp)); return kp; }
template <int PH> __global__ void __launch_bounds__(512, 2) k_phase(Params p_, int layer, int sub) {
    extern __shared__ __attribute__((aligned(16))) unsigned char lds[];
    Ctx c = make_ctx(lds);
    run_phase<PH>(*kparams(), c, layer, sub);
}
#ifdef DBG_VARIANTS
__device__ __forceinline__ void win_variant(PRM p, Ctx& c, int boff_tiles, int N, int npt, int ldp, unsigned* flag) {
    pg8::Gemm g{(const bf16*)(p.ws + WS_HB), (const bf16*)(p.ws + WS_WIN) + (size_t)boff_tiles * 256 * DM, MTOK, N, DM, DM, DM, 0, 0};
    pg8::StaticOrder S; S.init(MTOK, N, c.G, c.bid);
    pg8::EpiWin E{(bf16*)(p.ws + WS_PROJ), ldp, npt, (bf16*)(p.ws + WS_GATES), GATE_LD, p.b_gate, flag};
    pg8::gemm_phase<pg8::EpiWin, pg8::StaticOrder, true, true>(c.lds, g, S, E, c.tid);
}
__global__ void __launch_bounds__(512, 2) k_variant(Params p_, int v, int check) {
    extern __shared__ __attribute__((aligned(16))) unsigned char lds[];
    Ctx c = make_ctx(lds); PRM p = *kparams();
    unsigned* flag = check ? (unsigned*)(p.ws + WS_CTL) + 1024 + 64 * v : nullptr;
    if (v == 0) win_variant(p, c, 0, NWIN, NPT, PROJ_LD, flag);
    if (v == 1) win_variant(p, c, 0, NWIN, 53, NWIN, flag);
    if (v == 2) win_variant(p, c, 21, 8192, 0, PROJ_LD, flag);
    if (v == 3) win_variant(p, c, 0, 5376, NPT, PROJ_LD, flag);
    if (v == 4) win_variant(p, c, 0, 13312, NPT, PROJ_LD, flag);
    if (v == 5) win_variant(p, c, 0, 5120, NPT, PROJ_LD, flag);
}
__global__ void k_encode(Params p_) {
    PRM p = *kparams(); const unsigned* f = (const unsigned*)(p.ws + WS_CTL) + 1024;
    const size_t i = (size_t)blockIdx.x * blockDim.x + threadIdx.x;
    if (i < (size_t)MTOK * DM) { float v = 0.f; if (i == 0) { unsigned m = 0; for (int k = 0; k < 6; ++k) m |= (f[64 * k] ? 1u : 0u) << k; v = (10.f + (float)m) * 100.f; } p.out[i] = v; }
}
#endif
#ifndef MK_ONE_LAUNCH
#define MK_ONE_LAUNCH 1
#endif
#if MK_ONE_LAUNCH
__global__ void __launch_bounds__(512, 2) k_mega(Params p_) {
    extern __shared__ __attribute__((aligned(16))) unsigned char lds[];
    Ctx c = make_ctx(lds);
    volatile LAS unsigned* MISC = (volatile LAS unsigned*)(c.lds + MISC_OFF);
    if (c.tid < 32) MISC[c.tid] = 0u;
    __syncthreads();
    XcdBarrier bar = xcd_barrier_post((unsigned*)(kparams()->ws + WS_CTL) + CW_BAR, MISC + 8, c.wave);
#define GBAR() xcd_barrier(bar)
    for (int layer = 0; layer < DBG_LAYERS; ++layer) {
        run_phase<PH_CONVERT>(*kparams(), c, layer, 0); GBAR();
#ifdef DBG_REPEAT_CONV
        run_phase<PH_CONVERT>(*kparams(), c, layer, 0); GBAR();
#endif
        for (int sub = 0; sub < DBG_SUBS; ++sub) {
            if (sub != 1) { run_phase<PH_GU>(*kparams(), c, layer, sub); GBAR();
#ifdef DBG_REPEAT_GU
                run_phase<PH_GU>(*kparams(), c, layer, sub); GBAR();
#endif
#ifdef DBG_REPEAT_DOWN
                run_phase<PH_DOWN>(*kparams(), c, layer, sub, 1); GBAR();
#endif
                run_phase<PH_DOWN>(*kparams(), c, layer, sub); GBAR(); }
            else {
                run_phase<PH_WIN>(*kparams(), c, layer, sub); GBAR();
#ifdef DBG_REPEAT_WIN
                run_phase<PH_WIN>(*kparams(), c, layer, sub); GBAR();
#endif
                run_phase<PH_PREP>(*kparams(), c, layer, sub); GBAR();
#ifdef DBG_REPEAT_THIN
                run_phase<PH_PREP>(*kparams(), c, layer, sub, 1); GBAR(); run_phase<PH_UP>(*kparams(), c, layer, sub); GBAR();
#endif
                run_phase<PH_UP>(*kparams(), c, layer, sub); GBAR();
                run_phase<PH_MIX>(*kparams(), c, layer, sub); GBAR();
#ifdef DBG_REPEAT_MIX
                run_phase<PH_MIX>(*kparams(), c, layer, sub, 1); GBAR();
#endif
                run_phase<PH_POST>(*kparams(), c, layer, sub); GBAR();
#ifdef DBG_REPEAT_THIN
                run_phase<PH_POST>(*kparams(), c, layer, sub); GBAR();
#endif
                run_phase<PH_MERGE>(*kparams(), c, layer, sub); GBAR();
#ifdef DBG_REPEAT_MERGE
                run_phase<PH_MERGE>(*kparams(), c, layer, sub); GBAR();
#endif

                run_phase<PH_WOUT>(*kparams(), c, layer, sub); GBAR();
            }
#ifdef DBG_REPEAT_LN
            run_phase<PH_LN>(*kparams(), c, layer, sub, 1); GBAR();
#endif
            run_phase<PH_LN>(*kparams(), c, layer, sub);
            if (!(layer == DBG_LAYERS - 1 && sub == DBG_SUBS - 1)) GBAR();
        }
    }
#undef GBAR
}
#endif

template <int PH> static void launch_phase(const Params& p, int layer, int sub, int grid, hipStream_t stream) {
    static bool attr = false;
    if (!attr) { (void)hipFuncSetAttribute((const void*)k_phase<PH>, hipFuncAttributeMaxDynamicSharedMemorySize, LDS_BYTES); attr = true; }
    hipLaunchKernelGGL(k_phase<PH>, dim3(grid), dim3(512), LDS_BYTES, stream, p, layer, sub);
}
extern "C" void kernel_launch(void* const* d_in, const int* in_sizes, int n_in, void* d_out, int out_size, void* d_ws, size_t ws_size, hipStream_t stream) {
    if (n_in != 27 || in_sizes[0] != MTOK * DM || out_size != MTOK * DM || ws_size < WS_END) {
        fprintf(stderr, "kernel_launch: unexpected shapes: n_in %d in0 %d out %d ws %zu (need %zu); nothing launched\n", n_in, n_in > 0 ? in_sizes[0] : -1, out_size, ws_size, (size_t)WS_END); return; }
    static int grid = 0;
    if (grid == 0) { int dev = 0, cus = 0; if (hipGetDevice(&dev) != hipSuccess || hipDeviceGetAttribute(&cus, hipDeviceAttributeMultiprocessorCount, dev) != hipSuccess || cus <= 0) cus = 256; grid = cus; }
#ifdef DBG_POISON
    (void)hipMemsetAsync((char*)d_ws, 0xFF, WS_END, stream); (void)hipMemsetAsync(d_out, 0xFF, (size_t)out_size * 4, stream);
#endif
    (void)hipMemsetAsync((char*)d_ws + WS_CTL, 0, CTL_ZERO_BYTES, stream);
    Params p{};
    p.x = (const float*)d_in[0]; p.pos = (const int*)d_in[1]; p.ln_g = (const float*)d_in[2]; p.ln_b = (const float*)d_in[3];
    p.w_gu[0] = (const float*)d_in[4]; p.w_down[0] = (const float*)d_in[5]; p.w_gu[1] = (const float*)d_in[6]; p.w_down[1] = (const float*)d_in[7];
    p.w_in = (const float*)d_in[8]; p.b_gate = (const float*)d_in[9]; p.diff_lambda = (const float*)d_in[10]; p.diff_subln_g = (const float*)d_in[11];
    p.gla_w_gate2 = (const float*)d_in[12]; p.gla_b_gate = (const float*)d_in[13]; p.gla_norm_g = (const float*)d_in[14];
    p.mla_q_norm_g = (const float*)d_in[15]; p.mla_w_uq = (const float*)d_in[16]; p.mla_kv_norm_g = (const float*)d_in[17]; p.mla_w_ukv = (const float*)d_in[18];
    p.ssd_conv_w = (const float*)d_in[19]; p.ssd_conv_b = (const float*)d_in[20]; p.ssd_dt_bias = (const float*)d_in[21]; p.ssd_a_log = (const float*)d_in[22]; p.ssd_d = (const float*)d_in[23]; p.ssd_norm_g = (const float*)d_in[24];
    p.w_branch = (const float*)d_in[25]; p.w_out = (const float*)d_in[26];
    p.out = (float*)d_out; p.ws = (unsigned char*)d_ws;
    for (int l = 0; l < 4; ++l) p.lam_init[l] = (float)(0.8 - 0.6 * exp(-0.3 * l));
    for (int i = 0; i < 8; ++i) p.inv_d[i] = (float)pow(500000.0, -(double)(2 * i) / 16.0);
    for (int i = 0; i < 32; ++i) p.inv_m[i] = (float)pow(500000.0, -(double)(2 * i) / 64.0);
#ifdef DBG_VARIANTS
    { static bool attr2 = false; if (!attr2) { (void)hipFuncSetAttribute((const void*)k_variant, hipFuncAttributeMaxDynamicSharedMemorySize, LDS_BYTES); attr2 = true; }
      launch_phase<PH_CONVERT>(p, 0, 0, grid, stream);
      for (int rep = 0; rep < 2; ++rep) for (int v = 0; v < 6; ++v) { hipLaunchKernelGGL(k_variant, dim3(grid), dim3(512), LDS_BYTES, stream, p, v, 0); hipLaunchKernelGGL(k_variant, dim3(grid), dim3(512), LDS_BYTES, stream, p, v, 1); }
      hipLaunchKernelGGL(k_encode, dim3((unsigned)(((size_t)MTOK * DM + 255) / 256)), dim3(256), 0, stream, p);
      return; }
#endif
#if MK_ONE_LAUNCH
    static bool attr = false;
    if (!attr) { (void)hipFuncSetAttribute((const void*)k_mega, hipFuncAttributeMaxDynamicSharedMemorySize, LDS_BYTES); attr = true; }
    hipLaunchKernelGGL(k_mega, dim3(grid), dim3(512), LDS_BYTES, stream, p);
#else
    for (int layer = 0; layer < DBG_LAYERS; ++layer) {
        launch_phase<PH_CONVERT>(p, layer, 0, grid, stream);
        for (int sub = 0; sub < DBG_SUBS; ++sub) {
            if (sub != 1) { launch_phase<PH_GU>(p, layer, sub, grid, stream); launch_phase<PH_DOWN>(p, layer, sub, grid, stream); }
            else { launch_phase<PH_WIN>(p, layer, sub, grid, stream); launch_phase<PH_PREP>(p, layer, sub, grid, stream); launch_phase<PH_UP>(p, layer, sub, grid, stream); launch_phase<PH_MIX>(p, layer, sub, grid, stream);
                   launch_phase<PH_POST>(p, layer, sub, grid, stream); launch_phase<PH_MERGE>(p, layer, sub, grid, stream); launch_phase<PH_WOUT>(p, layer, sub, grid, stream); }
            launch_phase<PH_LN>(p, layer, sub, grid, stream);
        }
    }
#endif
    const hipError_t le = hipPeekAtLastError();
    if (le != hipSuccess) fprintf(stderr, "kernel_launch: launch failed: %s\n", hipGetErrorName(le));
}
```
